# Optimizing an MI355X kernel written in HIP

```python
import math
import jax, jax.numpy as jnp
from jax import lax
import numpy as np


D_MODEL = 1024
BATCH = 16
SEQ = 2048
DEPTH = 2

N_MIXERS = 4
HEADS = 4
HEAD_DIM = D_MODEL // (N_MIXERS * HEADS)
GROUP_WIDTH = HEADS * HEAD_DIM
MIX_WIDTH = N_MIXERS * GROUP_WIDTH
D_FF = 4 * D_MODEL
LN_EPS = 1e-5
NEG = -1e30

M_QK_DIM = HEAD_DIM // 2
M_CHUNK = 64
M_CONV = 4

DIL_PATTERNS = ((128, 1), (512, 4), (2048, 16))

IDX_HEADS = 4
IDX_DIM = 64
DSA_TOPK = 256
DSA_QBLOCK = 128

NSA_CMP_LEN = 32
NSA_CMP_STRIDE = 16
NSA_SEL_LEN = 64
NSA_TOPN = 16
NSA_WINDOW = 512
NSA_CMP_HIDDEN = 256
NSA_QBLOCK = 64
NSA_FORCE = 1e9

NUM_BUCKETS = 32
MAX_DISTANCE = 128
N_BIAS_HEADS = 3 * HEADS

ALPHA = (2 * DEPTH) ** 0.25
BETA = (8 * DEPTH) ** -0.25

IN_SPLITS = (
    ('a_q', HEADS * M_QK_DIM), ('a_k', HEADS * M_QK_DIM), ('a_v', GROUP_WIDTH),
    ('a_i', HEADS), ('a_f', HEADS), ('a_o', GROUP_WIDTH),
    ('b_q', GROUP_WIDTH), ('b_k', GROUP_WIDTH), ('b_v', GROUP_WIDTH),
    ('c_q', GROUP_WIDTH), ('c_k', HEAD_DIM), ('c_v', HEAD_DIM),
    ('c_iq', IDX_HEADS * IDX_DIM), ('c_ik', IDX_DIM), ('c_iw', IDX_HEADS),
    ('d_q', GROUP_WIDTH), ('d_kc', HEAD_DIM), ('d_vc', HEAD_DIM),
    ('d_ks', HEAD_DIM), ('d_vs', HEAD_DIM), ('d_kw', HEAD_DIM), ('d_vw', HEAD_DIM),
    ('d_g', 3 * HEADS),
)
D_IN = sum(w for _, w in IN_SPLITS)

kernel_name = 'hybrid_parallel_mixers_deepnorm'


def _col_range(name):
    off = 0
    for n, w in IN_SPLITS:
        if n == name:
            return off, off + w
        off += w
    raise KeyError(name)


def split_cols(z):
    out = {}
    off = 0
    for n, w in IN_SPLITS:
        out[n] = z[..., off:off + w]
        off += w
    return out


def layer_norm(x, g, b):
    xf = x.astype(jnp.float32)
    mu = jnp.mean(xf, axis=-1, keepdims=True)
    var = jnp.mean(jnp.square(xf - mu), axis=-1, keepdims=True)
    return ((xf - mu) * lax.rsqrt(var + LN_EPS) * g + b).astype(x.dtype)


def t5_bucket(dist):
    n = jnp.maximum(dist, 0)
    max_exact = NUM_BUCKETS // 2
    nf = jnp.maximum(n, max_exact).astype(jnp.float32)
    large = max_exact + (jnp.log(nf / max_exact) / math.log(MAX_DISTANCE / max_exact)
                         * (NUM_BUCKETS - max_exact)).astype(jnp.int32)
    large = jnp.minimum(large, NUM_BUCKETS - 1)
    return jnp.where(n < max_exact, n, large)


def masked_softmax(logits, mask):
    logits = jnp.where(mask, logits.astype(jnp.float32), NEG)
    m = jnp.max(logits, axis=-1, keepdims=True)
    p = jnp.where(mask, jnp.exp(logits - m), 0.0)
    den = jnp.maximum(jnp.sum(p, axis=-1, keepdims=True), 1e-30)
    return p / den, (m + jnp.log(den))[..., 0]


def gather_rows(t, idx):
    return jax.vmap(lambda tt, ii: tt[ii])(t, idx)


def causal_conv(x, w):
    c = x.shape[-1]
    return lax.conv_general_dilated(
        x, w[:, None, :].astype(x.dtype), window_strides=(1,),
        padding=((w.shape[0] - 1, 0),), dimension_numbers=('NWC', 'WIO', 'NWC'),
        feature_group_count=c)


def mlstm_mixer(q, k, v, i_pre, f_pre, o_pre, norm_g):
    B, S, H, DK = q.shape
    DV = v.shape[-1]
    nc = S // M_CHUNK
    f32 = jnp.float32

    def chunks(t):
        t = t.astype(f32).reshape((B, nc, M_CHUNK) + t.shape[2:])
        return jnp.transpose(t, (1, 0, 3, 2) + tuple(range(4, t.ndim)))

    qc = chunks(q)
    kc = chunks(k * (DK ** -0.5))
    vc = chunks(v)
    ic = chunks(i_pre)
    fc = chunks(jax.nn.log_sigmoid(f_pre.astype(f32)))
    tri = jnp.tril(jnp.ones((M_CHUNK, M_CHUNK), dtype=bool))

    def step(carry, xs):
        C, n, m = carry
        qb, kb, vb, ib, fb = xs
        b = jnp.cumsum(fb, axis=-1)
        D = jnp.where(tri, b[..., :, None] - b[..., None, :] + ib[..., None, :], NEG)
        inter = b + m[..., None]
        m_t = jnp.maximum(inter, jnp.max(D, axis=-1))
        sc = jnp.einsum('bhtd,bhsd->bhts', qb, kb) * jnp.exp(D - m_t[..., None])
        wi = jnp.exp(inter - m_t)
        num = jnp.einsum('bhts,bhsv->bhtv', sc, vb) + wi[..., None] * jnp.einsum('bhtd,bhdv->bhtv', qb, C)
        den = jnp.sum(sc, axis=-1) + wi * jnp.einsum('bhtd,bhd->bht', qb, n)
        h = num / jnp.maximum(jnp.abs(den), jnp.exp(-m_t))[..., None]
        bL = b[..., -1]
        g = bL[..., None] - b + ib
        m_new = jnp.maximum(bL + m, jnp.max(g, axis=-1))
        ws = jnp.exp(g - m_new[..., None])
        wc = jnp.exp(bL + m - m_new)
        C = wc[..., None, None] * C + jnp.einsum('bhs,bhsd,bhsv->bhdv', ws, kb, vb)
        n = wc[..., None] * n + jnp.einsum('bhs,bhsd->bhd', ws, kb)
        return (C, n, m_new), h

    init = (jnp.zeros((B, H, DK, DV), f32), jnp.zeros((B, H, DK), f32), jnp.zeros((B, H), f32))
    _, hc = lax.scan(step, init, (qc, kc, vc, ic, fc))
    h = jnp.transpose(hc, (1, 0, 3, 2, 4)).reshape(B, S, H, DV)
    h = jax.nn.sigmoid(o_pre.astype(f32)).reshape(B, S, H, DV) * h
    mu = jnp.mean(h, axis=-1, keepdims=True)
    var = jnp.mean(jnp.square(h - mu), axis=-1, keepdims=True)
    h = (h - mu) * lax.rsqrt(var + LN_EPS)
    return (h.reshape(B, S, H * DV) * norm_g).astype(v.dtype)


def dilated_branch(q, k, v, bias_tab, window, dil):
    B, S, H, hd = q.shape
    W = window // dil
    L = S // dil
    nb = -(-L // W)
    Lp = nb * W

    def residues(t):
        t = jnp.transpose(t.reshape(B, L, dil, H, hd), (0, 2, 1, 3, 4))
        t = jnp.pad(t, ((0, 0), (0, 0), (0, Lp - L), (0, 0), (0, 0)))
        return t.reshape(B, dil, nb, W, H, hd)

    qb, kb, vb = residues(q), residues(k), residues(v)
    shift = lambda t: jnp.pad(t, ((0, 0), (0, 0), (1, 0), (0, 0), (0, 0), (0, 0)))[:, :, :-1]
    kk = jnp.concatenate([shift(kb), kb], axis=3)
    vv = jnp.concatenate([shift(vb), vb], axis=3)
    qi = jnp.arange(W)[:, None]
    ki = jnp.arange(2 * W)[None, :]
    j = W + qi - ki
    band = (j >= 0) & (j <= W)
    first_ok = (jnp.arange(nb)[:, None, None] > 0) | (ki[None] >= W)
    mask = (band[None] & first_ok)[None, None, :, None]
    bias = jnp.transpose(bias_tab[t5_bucket(j * dil)], (2, 0, 1))
    logits = jnp.einsum('brnqhd,brnkhd->brnhqk', qb, kk).astype(jnp.float32) * hd ** -0.5 + bias
    p, lse = masked_softmax(logits, mask)
    o = jnp.einsum('brnhqk,brnkhd->brnqhd', p, vv.astype(jnp.float32))
    o = jnp.transpose(o.reshape(B, dil, Lp, H, hd)[:, :, :L], (0, 2, 1, 3, 4)).reshape(B, S, H, hd)
    lse = jnp.transpose(lse, (0, 1, 2, 4, 3)).reshape(B, dil, Lp, H)[:, :, :L]
    lse = jnp.transpose(lse, (0, 2, 1, 3)).reshape(B, S, H)
    return o, lse


def dilated_mixer(q, k, v, bias_tab):
    B, S, H, hd = q.shape
    outs, lses = [], []
    for window, dil in DIL_PATTERNS:
        o, lse = dilated_branch(q, k, v, bias_tab, window, dil)
        outs.append(o)
        lses.append(lse)
    wts = jax.nn.softmax(jnp.stack(lses, axis=0), axis=0)
    o = jnp.sum(wts[..., None] * jnp.stack(outs, axis=0), axis=0)
    return o.reshape(B, S, H * hd).astype(q.dtype)


def dsa_mixer(q, k, v, iq, ik, iw, bias_tab):
    B, S, H, hd = q.shape
    topk = min(DSA_TOPK, S // 4)
    kpos = jnp.arange(S)
    iw = iw.astype(jnp.float32) * (IDX_HEADS * IDX_DIM) ** -0.5

    def block(i):
        s0 = i * DSA_QBLOCK
        tq = s0 + jnp.arange(DSA_QBLOCK)
        qb = lax.dynamic_slice_in_dim(q, s0, DSA_QBLOCK, axis=1)
        iqb = lax.dynamic_slice_in_dim(iq, s0, DSA_QBLOCK, axis=1)
        iwb = lax.dynamic_slice_in_dim(iw, s0, DSA_QBLOCK, axis=1)
        rel = jax.nn.relu(jnp.einsum('bqhd,bsd->bqhs', iqb, ik).astype(jnp.float32))
        score = jnp.einsum('bqhs,bqh->bqs', rel, iwb)
        score = jnp.where((kpos[None, :] <= tq[:, None])[None], score, NEG)
        _, idx = lax.top_k(score, topk)
        kg = gather_rows(k, idx)
        vg = gather_rows(v, idx)
        dist = tq[None, :, None] - idx
        bias = jnp.transpose(bias_tab[t5_bucket(dist)], (0, 3, 1, 2))
        logits = jnp.einsum('bqhd,bqkd->bhqk', qb, kg).astype(jnp.float32) * hd ** -0.5 + bias
        p, _ = masked_softmax(logits, (dist >= 0)[:, None])
        return jnp.einsum('bhqk,bqkd->bqhd', p, vg.astype(jnp.float32))

    out = lax.map(block, jnp.arange(S // DSA_QBLOCK))
    return jnp.transpose(out, (1, 0, 2, 3, 4)).reshape(B, S, H * hd).astype(q.dtype)


def nsa_compress(t, pos, w1, w2):
    B, S, hd = t.shape
    n_cmp = (S - NSA_CMP_LEN) // NSA_CMP_STRIDE + 1
    idx = jnp.arange(n_cmp)[:, None] * NSA_CMP_STRIDE + jnp.arange(NSA_CMP_LEN)[None, :]
    blocks = (t[:, idx] + pos).reshape(B, n_cmp, NSA_CMP_LEN * hd)
    return jax.nn.silu(blocks @ w1) @ w2


def nsa_mixer(q, kc, vc, ks, vs, kw, vw, gates, cmp_pos, cmp_w1, cmp_w2, bias_tab):
    B, S, H, hd = q.shape
    f32 = jnp.float32
    scale = hd ** -0.5
    kcmp = nsa_compress(kc, cmp_pos[0], cmp_w1[0], cmp_w2[0])
    vcmp = nsa_compress(vc, cmp_pos[1], cmp_w1[1], cmp_w2[1]).astype(f32)
    n_cmp = kcmp.shape[1]
    cmp_start = jnp.arange(n_cmp) * NSA_CMP_STRIDE
    cmp_end = cmp_start + NSA_CMP_LEN - 1
    n_sel = S // NSA_SEL_LEN
    topn = min(NSA_TOPN, n_sel)
    sel_start = jnp.arange(n_sel) * NSA_SEL_LEN
    overlap = jnp.clip(jnp.minimum(cmp_start[:, None] + NSA_CMP_LEN, sel_start[None] + NSA_SEL_LEN)
                       - jnp.maximum(cmp_start[:, None], sel_start[None]), 0).astype(f32) / NSA_CMP_LEN
    kw_pad = jnp.pad(kw, ((0, 0), (NSA_WINDOW, 0), (0, 0)))
    vw_pad = jnp.pad(vw, ((0, 0), (NSA_WINDOW, 0), (0, 0)))
    g = jax.nn.sigmoid(gates.astype(f32)).reshape(B, S, H, 3)
    jj = jnp.arange(n_sel)

    def block(i):
        s0 = i * NSA_QBLOCK
        tq = s0 + jnp.arange(NSA_QBLOCK)
        qb = lax.dynamic_slice_in_dim(q, s0, NSA_QBLOCK, axis=1)
        dist_c = tq[:, None] - cmp_end[None]
        bias_c = jnp.transpose(bias_tab[t5_bucket(dist_c)], (2, 0, 1))[None]
        lc = jnp.einsum('bqhd,bcd->bhqc', qb, kcmp).astype(f32) * scale + bias_c
        pc, _ = masked_softmax(lc, (dist_c >= 0)[None, None])
        o_c = jnp.einsum('bhqc,bcd->bqhd', pc, vcmp)
        imp = jnp.einsum('bhqc,cj->bqj', pc, overlap)
        cur = tq // NSA_SEL_LEN
        forced = (jj[None] == 0) | (jj[None] == cur[:, None]) | (jj[None] == cur[:, None] - 1)
        admissible = sel_start[None] <= tq[:, None]
        imp = jnp.where(forced[None], NSA_FORCE, imp)
        imp = jnp.where(admissible[None], imp, NEG)
        _, sel = lax.top_k(imp, topn)
        tok = (sel[..., None] * NSA_SEL_LEN + jnp.arange(NSA_SEL_LEN)).reshape(B, NSA_QBLOCK, topn * NSA_SEL_LEN)
        ksg = gather_rows(ks, tok)
        vsg = gather_rows(vs, tok)
        dist_s = tq[None, :, None] - tok
        bias_s = jnp.transpose(bias_tab[t5_bucket(dist_s)], (0, 3, 1, 2))
        ls = jnp.einsum('bqhd,bqkd->bhqk', qb, ksg).astype(f32) * scale + bias_s
        ps, _ = masked_softmax(ls, (dist_s >= 0)[:, None])
        o_s = jnp.einsum('bhqk,bqkd->bqhd', ps, vsg.astype(f32))
        kwb = lax.dynamic_slice_in_dim(kw_pad, s0, NSA_WINDOW + NSA_QBLOCK, axis=1)
        vwb = lax.dynamic_slice_in_dim(vw_pad, s0, NSA_WINDOW + NSA_QBLOCK, axis=1)
        kpos = s0 - NSA_WINDOW + jnp.arange(NSA_WINDOW + NSA_QBLOCK)
        dist_w = tq[:, None] - kpos[None]
        valid_w = (dist_w >= 0) & (dist_w < NSA_WINDOW) & (kpos[None] >= 0)
        bias_w = jnp.transpose(bias_tab[t5_bucket(dist_w)], (2, 0, 1))[None]
        lw = jnp.einsum('bqhd,bkd->bhqk', qb, kwb).astype(f32) * scale + bias_w
        pw, _ = masked_softmax(lw, valid_w[None, None])
        o_w = jnp.einsum('bhqk,bkd->bqhd', pw, vwb.astype(f32))
        gb = lax.dynamic_slice_in_dim(g, s0, NSA_QBLOCK, axis=1)
        return gb[..., 0:1] * o_c + gb[..., 1:2] * o_s + gb[..., 2:3] * o_w

    out = lax.map(block, jnp.arange(S // NSA_QBLOCK))
    return jnp.transpose(out, (1, 0, 2, 3, 4)).reshape(B, S, H * hd).astype(q.dtype)


def hybrid_layer(x, w_in, b_in, a_conv, a_norm, d_cmp_pos, d_cmp_w1, d_cmp_w2, w_out, b_out,
                 ln1_g, ln1_b, w_ff1, b_ff1, w_ff2, b_ff2, ln2_g, ln2_b, rel_bias):
    B, S, _ = x.shape
    H, hd = HEADS, HEAD_DIM
    z = split_cols(jnp.einsum('bsd,de->bse', x, w_in) + b_in)
    qk = jax.nn.silu(causal_conv(jnp.concatenate([z['a_q'], z['a_k']], axis=-1), a_conv))
    a_q, a_k = jnp.split(qk, 2, axis=-1)
    out_a = mlstm_mixer(a_q.reshape(B, S, H, M_QK_DIM), a_k.reshape(B, S, H, M_QK_DIM),
                        z['a_v'].reshape(B, S, H, hd), z['a_i'], z['a_f'], z['a_o'], a_norm)
    out_b = dilated_mixer(z['b_q'].reshape(B, S, H, hd), z['b_k'].reshape(B, S, H, hd),
                          z['b_v'].reshape(B, S, H, hd), rel_bias[:, 0:H])
    out_c = dsa_mixer(z['c_q'].reshape(B, S, H, hd), z['c_k'], z['c_v'],
                      z['c_iq'].reshape(B, S, IDX_HEADS, IDX_DIM), z['c_ik'], z['c_iw'],
                      rel_bias[:, H:2 * H])
    out_d = nsa_mixer(z['d_q'].reshape(B, S, H, hd), z['d_kc'], z['d_vc'], z['d_ks'], z['d_vs'],
                      z['d_kw'], z['d_vw'], z['d_g'], d_cmp_pos, d_cmp_w1, d_cmp_w2,
                      rel_bias[:, 2 * H:3 * H])
    mixed = jnp.concatenate([out_a, out_b, out_c, out_d], axis=-1).astype(x.dtype)
    x = layer_norm(ALPHA * x + (mixed @ w_out + b_out), ln1_g, ln1_b)
    ff = jnp.square(jax.nn.relu(x @ w_ff1 + b_ff1)) @ w_ff2 + b_ff2
    return layer_norm(ALPHA * x + ff, ln2_g, ln2_b)


def setup_inputs(seed: int = 0) -> dict:
    key = jax.random.key(seed)
    ks = jax.random.split(key, 20)
    f32 = jnp.float32

    def nrm(k, shape, scale):
        return scale * jax.random.normal(k, shape, f32)

    x = nrm(ks[0], (BATCH, SEQ, D_MODEL), 1.0)
    w_in = nrm(ks[1], (DEPTH, D_MODEL, D_IN), D_MODEL ** -0.5)
    f0, f1 = _col_range('a_f')
    b_in = nrm(ks[2], (DEPTH, D_IN), 0.02)
    b_in = b_in.at[:, f0:f1].set(3.0 + 3.0 * jax.random.uniform(ks[3], (DEPTH, f1 - f0), f32))
    a_conv = nrm(ks[4], (DEPTH, M_CONV, 2 * HEADS * M_QK_DIM), M_CONV ** -0.5)
    a_norm = 1.0 + nrm(ks[5], (DEPTH, GROUP_WIDTH), 0.02)
    d_cmp_pos = nrm(ks[6], (DEPTH, 2, NSA_CMP_LEN, HEAD_DIM), 0.02)
    d_cmp_w1 = nrm(ks[7], (DEPTH, 2, NSA_CMP_LEN * HEAD_DIM, NSA_CMP_HIDDEN), (NSA_CMP_LEN * HEAD_DIM) ** -0.5)
    d_cmp_w2 = nrm(ks[8], (DEPTH, 2, NSA_CMP_HIDDEN, HEAD_DIM), NSA_CMP_HIDDEN ** -0.5)
    w_out = nrm(ks[9], (DEPTH, MIX_WIDTH, D_MODEL), BETA * MIX_WIDTH ** -0.5)
    b_out = nrm(ks[10], (DEPTH, D_MODEL), 0.02)
    ln1_g = 1.0 + nrm(ks[11], (DEPTH, D_MODEL), 0.02)
    ln1_b = nrm(ks[12], (DEPTH, D_MODEL), 0.02)
    w_ff1 = nrm(ks[13], (DEPTH, D_MODEL, D_FF), D_MODEL ** -0.5)
    b_ff1 = nrm(ks[14], (DEPTH, D_FF), 0.02)
    w_ff2 = nrm(ks[15], (DEPTH, D_FF, D_MODEL), BETA * D_FF ** -0.5)
    b_ff2 = nrm(ks[16], (DEPTH, D_MODEL), 0.02)
    ln2_g = 1.0 + nrm(ks[17], (DEPTH, D_MODEL), 0.02)
    ln2_b = nrm(ks[18], (DEPTH, D_MODEL), 0.02)
    rel_bias = nrm(ks[19], (NUM_BUCKETS, N_BIAS_HEADS), 0.2)
    return {'x': x, 'w_in': w_in, 'b_in': b_in, 'a_conv': a_conv, 'a_norm': a_norm,
            'd_cmp_pos': d_cmp_pos, 'd_cmp_w1': d_cmp_w1, 'd_cmp_w2': d_cmp_w2,
            'w_out': w_out, 'b_out': b_out, 'ln1_g': ln1_g, 'ln1_b': ln1_b,
            'w_ff1': w_ff1, 'b_ff1': b_ff1, 'w_ff2': w_ff2, 'b_ff2': b_ff2,
            'ln2_g': ln2_g, 'ln2_b': ln2_b, 'rel_bias': rel_bias}


def reference(x, w_in, b_in, a_conv, a_norm, d_cmp_pos, d_cmp_w1, d_cmp_w2, w_out, b_out,
              ln1_g, ln1_b, w_ff1, b_ff1, w_ff2, b_ff2, ln2_g, ln2_b, rel_bias):
    h = x
    for l in range(DEPTH):
        h = hybrid_layer(h, w_in[l], b_in[l], a_conv[l], a_norm[l], d_cmp_pos[l], d_cmp_w1[l],
                         d_cmp_w2[l], w_out[l], b_out[l], ln1_g[l], ln1_b[l], w_ff1[l], b_ff1[l],
                         w_ff2[l], b_ff2[l], ln2_g[l], ln2_b[l], rel_bias)
    return h
```

```cpp
#include <hip/hip_runtime.h>
#include <hip/hip_cooperative_groups.h>
#include <cstdio>
#include <cstdint>
namespace cg = cooperative_groups;

typedef unsigned short bf16_t;
typedef short bf16x8 __attribute__((ext_vector_type(8)));
typedef float f32x4 __attribute__((ext_vector_type(4)));

constexpr int D = 1024, BATCH = 16, SEQ = 2048, M = BATCH * SEQ, DEPTH = 2, NH = 4, HD = 64, DFF = 4096, DIN = 2904, NZ = 3072;
constexpr float LN_EPS = 1e-5f;
constexpr float ALPHA = 1.4142135623730951f;
constexpr float LOG2E = 1.4426950408889634f;
constexpr float C2 = 0.125f * LOG2E;
constexpr int ZC_AQ = 0, ZC_AK = 128, ZC_AV = 256, ZC_AO = 512, ZC_BQ = 768, ZC_BK = 1024, ZC_BV = 1280, ZC_CQ = 1536, ZC_CK = 1792, ZC_CV = 1856,
              ZC_CIQ = 1920, ZC_CIK = 2176, ZC_DQ = 2240, ZC_DKC = 2496, ZC_DVC = 2560, ZC_DKS = 2624, ZC_DVS = 2688, ZC_DKW = 2752, ZC_DVW = 2816, ZC_SM = 2880;
constexpr int MIX_A = 0, MIX_B = 256, MIX_C = 512, MIX_D = 768;
constexpr int NCMP = 127;

__host__ __device__ constexpr int orig_col(int n) {
    return n < 512 ? n : n < 2240 ? n + 8 : n < 2880 ? n + 12 : n < 2884 ? 512 + (n - 2880) : n < 2888 ? 516 + (n - 2884) : n < 2892 ? 2248 + (n - 2888) : n < 2904 ? n : -1;
}

constexpr size_t MiB = 1u << 20;
constexpr size_t WS_CTL = 0;
constexpr size_t WS_WIN = 1 * MiB;
constexpr size_t WS_WOUT = WS_WIN + 12 * MiB;
constexpr size_t WS_WFF1 = WS_WOUT + 4 * MiB;
constexpr size_t WS_WFF2 = WS_WFF1 + 16 * MiB;
constexpr size_t WS_BINP = WS_WFF2 + 16 * MiB;
constexpr size_t WS_KCMP = WS_BINP + 1 * MiB;
constexpr size_t WS_MU = WS_KCMP + 1 * MiB;
constexpr size_t WS_MSM = WS_MU + 16 * MiB;
constexpr size_t WS_ZS = WS_MSM + 1 * MiB;
constexpr size_t WS_XB = WS_ZS + 4 * MiB;
constexpr size_t WS_X1 = WS_XB + 64 * MiB;
constexpr size_t WS_Z = WS_X1 + 64 * MiB;
constexpr size_t WS_MIX = WS_Z + 192 * MiB;
constexpr size_t WS_END = WS_MIX + 64 * MiB;
constexpr size_t WS_HID = WS_Z;
constexpr size_t WS_Y1 = WS_Z;

struct Params {
    const float *x, *w_in, *b_in, *a_conv, *a_norm, *cmp_pos, *cmp_w1, *cmp_w2, *w_out, *b_out, *ln1_g, *ln1_b, *w_ff1, *b_ff1, *w_ff2, *b_ff2, *ln2_g, *ln2_b, *rel_bias;
    float* out; unsigned char* ws;
    int ph_lo, ph_hi;
};

__device__ __forceinline__ float bf2f(bf16_t u) { return __uint_as_float((unsigned)u << 16); }
__device__ __forceinline__ bf16_t f2bf(float f) { unsigned u = __float_as_uint(f); return (bf16_t)((u + 0x7fffu + ((u >> 16) & 1u)) >> 16); }
__device__ __forceinline__ unsigned pk2(float lo, float hi) { return (unsigned)f2bf(lo) | ((unsigned)f2bf(hi) << 16); }
__device__ __forceinline__ float wave_max(float v) {
#pragma unroll
    for (int o = 32; o; o >>= 1) v = fmaxf(v, __shfl_xor(v, o));
    return v;
}
__device__ __forceinline__ float wave_sum(float v) {
#pragma unroll
    for (int o = 32; o; o >>= 1) v += __shfl_xor(v, o);
    return v;
}
__device__ __forceinline__ float sigmoidf_(float x) { return 1.f / (1.f + __expf(-x)); }
__device__ __forceinline__ float siluf_(float x) { return x / (1.f + __expf(-x)); }

__device__ __forceinline__ int t5_bucket_small(int n) {
    if (n < 16) return n;
    int v = 16 + (int)(__logf((float)n * (1.f / 16.f)) * (16.f / 2.0794415416798357f));
    return v > 31 ? 31 : v;
}

__device__ __forceinline__ void fill_bias_table(float* bt, const float* rel_bias) {
    for (int i = threadIdx.x; i < 128 * 12; i += blockDim.x) {
        int d = i / 12, h = i % 12;
        int n = d, b;
        if (n < 16) b = n; else { float v = log2f((float)n * 0.0625f) * (16.f / 3.f); b = 16 + (int)v; if (b > 31) b = 31; }
        bt[i] = rel_bias[b * 12 + h] * LOG2E;
    }
}

template <bool PERM>
__device__ __forceinline__ void transpose_convert(const float* __restrict__ W, int K, int Nsrc, bf16_t* __restrict__ WT, int Ndst, float* tile, int item0, int& itemBase) {
    (void)item0;
    const int tilesK = K / 64, tilesN = Ndst / 64, nt = tilesK * tilesN;
    const int tid = threadIdx.x;
    for (int it = blockIdx.x; it < nt; it += gridDim.x) {
        const int k0 = (it / tilesN) * 64, n0 = (it % tilesN) * 64;
        __syncthreads();
        {
            const int nl = tid & 63, kq = tid >> 6;
            const int nsrc = PERM ? orig_col(n0 + nl) : (n0 + nl);
#pragma unroll
            for (int i = 0; i < 8; ++i) { const int kk = kq * 8 + i; tile[kk * 65 + nl] = (nsrc >= 0) ? W[(size_t)(k0 + kk) * Nsrc + nsrc] : 0.f; }
        }
        __syncthreads();
        {
            const int nl = tid >> 3, kc = tid & 7;
            uint4 o;
            o.x = pk2(tile[(kc * 8 + 0) * 65 + nl], tile[(kc * 8 + 1) * 65 + nl]);
            o.y = pk2(tile[(kc * 8 + 2) * 65 + nl], tile[(kc * 8 + 3) * 65 + nl]);
            o.z = pk2(tile[(kc * 8 + 4) * 65 + nl], tile[(kc * 8 + 5) * 65 + nl]);
            o.w = pk2(tile[(kc * 8 + 6) * 65 + nl], tile[(kc * 8 + 7) * 65 + nl]);
            *(uint4*)(WT + (size_t)(n0 + nl) * K + k0 + kc * 8) = o;
        }
    }
    (void)itemBase;
}

template <class Epi>
__device__ __forceinline__ void gemm_simple(const bf16_t* __restrict__ A, const bf16_t* __restrict__ Bt, int Mr, int N, int K, const Epi& epi) {
    const int wid = threadIdx.x >> 6, lane = threadIdx.x & 63, wm = wid >> 1, wn = wid & 1;
    const int tilesN = N / 128, ntiles = (Mr / 256) * tilesN;
    for (int t = blockIdx.x; t < ntiles; t += gridDim.x) {
        const int tm = t / tilesN, tn = t % tilesN;
        const int row0 = tm * 256 + wm * 64, col0 = tn * 128 + wn * 64;
        f32x4 acc[4][4];
#pragma unroll
        for (int i = 0; i < 4; ++i)
#pragma unroll
            for (int j = 0; j < 4; ++j) acc[i][j] = (f32x4){0.f, 0.f, 0.f, 0.f};
        const bf16_t* ap = A + (size_t)(row0 + (lane & 15)) * K + 8 * (lane >> 4);
        const bf16_t* bp = Bt + (size_t)(col0 + (lane & 15)) * K + 8 * (lane >> 4);
        for (int k0 = 0; k0 < K; k0 += 32) {
            bf16x8 a[4], b[4];
#pragma unroll
            for (int i = 0; i < 4; ++i) a[i] = *(const bf16x8*)(ap + (size_t)i * 16 * K + k0);
#pragma unroll
            for (int i = 0; i < 4; ++i) b[i] = *(const bf16x8*)(bp + (size_t)i * 16 * K + k0);
#pragma unroll
            for (int i = 0; i < 4; ++i)
#pragma unroll
                for (int j = 0; j < 4; ++j) acc[i][j] = __builtin_amdgcn_mfma_f32_16x16x32_bf16(b[j], a[i], acc[i][j], 0, 0, 0);
        }
#pragma unroll
        for (int i = 0; i < 4; ++i)
#pragma unroll
            for (int j = 0; j < 4; ++j) epi(row0 + i * 16 + (lane & 15), col0 + j * 16 + 4 * (lane >> 4), acc[i][j]);
    }
}

struct EpiIn {
    bf16_t* Z; float* ZS; const float* bias;
    __device__ __forceinline__ void operator()(int r, int c, f32x4 v) const {
        const f32x4 b = *(const f32x4*)(bias + c);
        v += b;
        if (c >= ZC_SM && c < ZC_SM + 32) *(f32x4*)(ZS + (size_t)r * 32 + (c - ZC_SM)) = v;
        const bool qc = (c >= ZC_BQ && c < ZC_BK) || (c >= ZC_CQ && c < ZC_CK) || (c >= ZC_DQ && c < ZC_DKC);
        if (qc) v *= C2;
        uint2 o; o.x = pk2(v[0], v[1]); o.y = pk2(v[2], v[3]);
        *(uint2*)(Z + (size_t)r * NZ + c) = o;
    }
};
struct EpiOut {
    float* Y; const float* res; const float* bias;
    __device__ __forceinline__ void operator()(int r, int c, f32x4 v) const {
        const f32x4 b = *(const f32x4*)(bias + c);
        const f32x4 x = *(const f32x4*)(res + (size_t)r * D + c);
        *(f32x4*)(Y + (size_t)r * D + c) = x * ALPHA + v + b;
    }
};
struct EpiFF1 {
    bf16_t* Hd; const float* bias;
    __device__ __forceinline__ void operator()(int r, int c, f32x4 v) const {
        const f32x4 b = *(const f32x4*)(bias + c);
        v += b;
#pragma unroll
        for (int i = 0; i < 4; ++i) { float t = fmaxf(v[i], 0.f); v[i] = t * t; }
        uint2 o; o.x = pk2(v[0], v[1]); o.y = pk2(v[2], v[3]);
        *(uint2*)(Hd + (size_t)r * DFF + c) = o;
    }
};
struct EpiFF2 {
    float* Y; const bf16_t* X1; const float* bias;
    __device__ __forceinline__ void operator()(int r, int c, f32x4 v) const {
        const f32x4 b = *(const f32x4*)(bias + c);
        const uint2 xr = *(const uint2*)(X1 + (size_t)r * D + c);
        f32x4 x; x[0] = bf2f((bf16_t)(xr.x & 0xffff)); x[1] = bf2f((bf16_t)(xr.x >> 16)); x[2] = bf2f((bf16_t)(xr.y & 0xffff)); x[3] = bf2f((bf16_t)(xr.y >> 16));
        *(f32x4*)(Y + (size_t)r * D + c) = x * ALPHA + v + b;
    }
};

__device__ __forceinline__ void ln_pass(const float* Y, const float* g, const float* b, float* outF, bf16_t* outB) {
    const int lane = threadIdx.x & 63, gw = blockIdx.x * 8 + (threadIdx.x >> 6), NGW = gridDim.x * 8;
    for (int m = gw; m < M; m += NGW) {
        const f32x4* yr = (const f32x4*)(Y + (size_t)m * D) + lane;
        f32x4 v[4]; float s = 0.f;
#pragma unroll
        for (int j = 0; j < 4; ++j) { v[j] = yr[64 * j]; s += (v[j][0] + v[j][1]) + (v[j][2] + v[j][3]); }
        const float mean = wave_sum(s) * (1.f / D); float s2 = 0.f;
#pragma unroll
        for (int j = 0; j < 4; ++j) { v[j] = v[j] - mean; s2 += (v[j][0] * v[j][0] + v[j][1] * v[j][1]) + (v[j][2] * v[j][2] + v[j][3] * v[j][3]); }
        const float rstd = rsqrtf(wave_sum(s2) * (1.f / D) + LN_EPS);
#pragma unroll
        for (int j = 0; j < 4; ++j) {
            const int c = 4 * lane + 256 * j;
            const f32x4 gg = *(const f32x4*)(g + c), bb = *(const f32x4*)(b + c);
            const f32x4 o = v[j] * rstd * gg + bb;
            if (outF) *(f32x4*)(outF + (size_t)m * D + c) = o;
            uint2 w; w.x = pk2(o[0], o[1]); w.y = pk2(o[2], o[3]);
            *(uint2*)(outB + (size_t)m * D + c) = w;
        }
    }
}

template <int NHH>
__device__ __forceinline__ void dot_row(const bf16_t* __restrict__ krow, const float* qs, float (&dot)[NHH]) {
#pragma unroll
    for (int h = 0; h < NHH; ++h) dot[h] = 0.f;
    const uint4* kr = (const uint4*)krow;
#pragma unroll
    for (int c8 = 0; c8 < 8; ++c8) {
        const uint4 kv = kr[c8];
        float kf[8];
        kf[0] = __uint_as_float(kv.x << 16); kf[1] = __uint_as_float(kv.x & 0xffff0000u);
        kf[2] = __uint_as_float(kv.y << 16); kf[3] = __uint_as_float(kv.y & 0xffff0000u);
        kf[4] = __uint_as_float(kv.z << 16); kf[5] = __uint_as_float(kv.z & 0xffff0000u);
        kf[6] = __uint_as_float(kv.w << 16); kf[7] = __uint_as_float(kv.w & 0xffff0000u);
#pragma unroll
        for (int h = 0; h < NHH; ++h)
#pragma unroll
            for (int j = 0; j < 8; ++j) dot[h] += kf[j] * qs[h * 64 + c8 * 8 + j];
    }
}

template <int NHH>
__device__ __forceinline__ void attn_batch(const bf16_t* __restrict__ Kp, const bf16_t* __restrict__ Vp, int pitch, int s, bool valid, int dist, int bh0,
                                           const float* qs, const float* bt, float (&m)[NHH], float (&l)[NHH], float (&acc)[NHH], int lane) {
    unsigned long long vm = __ballot(valid);
    if (vm == 0ull) return;
    float lg[NHH];
#pragma unroll
    for (int h = 0; h < NHH; ++h) lg[h] = -1e30f;
    if (valid) {
        float dot[NHH];
        dot_row<NHH>(Kp + (size_t)s * pitch, qs, dot);
        const int dd = dist > 127 ? 127 : dist;
#pragma unroll
        for (int h = 0; h < NHH; ++h) lg[h] = dot[h] + bt[dd * 12 + bh0 + h];
    }
    float p[NHH];
#pragma unroll
    for (int h = 0; h < NHH; ++h) {
        const float bm = wave_max(lg[h]);
        const float mn = fmaxf(m[h], bm);
        const float sc = exp2f(m[h] - mn);
        p[h] = valid ? exp2f(lg[h] - mn) : 0.f;
        l[h] = l[h] * sc + wave_sum(p[h]);
        acc[h] *= sc; m[h] = mn;
    }
    while (vm) {
        const int kk = __ffsll((long long)vm) - 1; vm &= vm - 1;
        const int sk = __shfl(s, kk);
        const float v = bf2f(Vp[(size_t)sk * pitch + lane]);
#pragma unroll
        for (int h = 0; h < NHH; ++h) acc[h] += __shfl(p[h], kk) * v;
    }
}

__device__ __forceinline__ void mixer_b_naive(const bf16_t* Z, bf16_t* MIX, const float* bt, float* qs_all) {
    const int lane = threadIdx.x & 63, wv = threadIdx.x >> 6, gw = blockIdx.x * 8 + wv, NGW = gridDim.x * 8;
    float* qs = qs_all + wv * 256;
    for (int it = gw; it < M; it += NGW) {
        const int b = it / SEQ, t = it % SEQ;
        const bf16_t* zb = Z + (size_t)b * SEQ * NZ;
        for (int h = 0; h < NH; ++h) {
            qs[lane] = bf2f(zb[(size_t)t * NZ + ZC_BQ + h * 64 + lane]);
            float m[1] = {-1e30f}, l[1] = {0.f}, acc[1] = {0.f};
            const bf16_t* Kp = zb + ZC_BK + h * 64; const bf16_t* Vp = zb + ZC_BV + h * 64;
#pragma unroll
            for (int br = 0; br < 3; ++br) {
                const int dil = br == 0 ? 1 : br == 1 ? 4 : 16;
                const int p = t / dil; const int J = p < 128 ? p : 128;
                for (int jb = 0; jb <= J; jb += 64) {
                    const int j = jb + lane;
                    attn_batch<1>(Kp, Vp, NZ, t - j * dil, j <= J, j * dil, h, qs, bt, m, l, acc, lane);
                }
            }
            MIX[(size_t)it * D + MIX_B + h * 64 + lane] = f2bf(acc[0] / fmaxf(l[0], 1e-30f));
        }
    }
}

__device__ __forceinline__ unsigned mono_key(float f) { unsigned u = __float_as_uint(f); return (u & 0x80000000u) ? ~u : (u | 0x80000000u); }

__device__ __forceinline__ void mixer_c_naive(const bf16_t* Z, const float* ZS, bf16_t* MIX, const float* bt, float* qs_all, unsigned* scl_all) {
    const int lane = threadIdx.x & 63, wv = threadIdx.x >> 6, gw = blockIdx.x * 8 + wv, NGW = gridDim.x * 8;
    float* qs = qs_all + wv * 256; unsigned* scl = scl_all + wv * 2048;
    for (int it0 = gw; it0 < M; it0 += NGW) {
        const int b = it0 / SEQ; int t = it0 % SEQ; t = (t & 1) ? (SEQ - 1 - (t >> 1)) : (t >> 1);
        const int it = b * SEQ + t;
        const bf16_t* zb = Z + (size_t)b * SEQ * NZ;
#pragma unroll
        for (int h = 0; h < 4; ++h) qs[h * 64 + lane] = bf2f(zb[(size_t)t * NZ + ZC_CIQ + h * 64 + lane]);
        float iw[4];
#pragma unroll
        for (int h = 0; h < 4; ++h) iw[h] = ZS[(size_t)it * 32 + 8 + h] * 0.0625f;
        const int ni = t / 64 + 1;
        for (int i = 0; i < ni; ++i) {
            const int s = lane + 64 * i;
            unsigned key = 0u;
            if (s <= t) {
                float dot[4];
                dot_row<4>(zb + (size_t)s * NZ + ZC_CIK, qs, dot);
                float sc = 0.f;
#pragma unroll
                for (int h = 0; h < 4; ++h) sc += fmaxf(dot[h], 0.f) * iw[h];
                if (sc == 0.f) sc = 0.f;
                key = mono_key(sc);
            }
            scl[i * 64 + lane] = key;
        }
        unsigned kreg[32];
#pragma unroll
        for (int i = 0; i < 32; ++i) kreg[i] = (i < ni) ? scl[i * 64 + lane] : 0u;
        unsigned selbits = 0u;
        if (t + 1 <= 256) {
#pragma unroll
            for (int i = 0; i < 32; ++i) if (i < ni && lane + 64 * i <= t) selbits |= 1u << i;
        } else {
            unsigned T = 0u;
            for (int bit = 31; bit >= 0; --bit) {
                const unsigned cand = T | (1u << bit);
                int cnt = 0;
#pragma unroll
                for (int i = 0; i < 32; ++i) if (i < ni) cnt += __popcll(__ballot(kreg[i] >= cand));
                if (cnt >= 256) T = cand;
            }
            int ngt = 0;
#pragma unroll
            for (int i = 0; i < 32; ++i) if (i < ni) ngt += __popcll(__ballot(kreg[i] > T));
            const int r = 256 - ngt; int run = 0;
            const unsigned long long lower = (1ull << lane) - 1ull;
#pragma unroll
            for (int i = 0; i < 32; ++i) if (i < ni) {
                const bool eq = kreg[i] == T;
                const unsigned long long em = __ballot(eq);
                const int pre = run + __popcll(em & lower);
                if (kreg[i] > T || (eq && pre < r)) selbits |= 1u << i;
                run += __popcll(em);
            }
        }
#pragma unroll
        for (int h = 0; h < 4; ++h) qs[h * 64 + lane] = bf2f(zb[(size_t)t * NZ + ZC_CQ + h * 64 + lane]);
        float m[4], l[4], acc[4];
#pragma unroll
        for (int h = 0; h < 4; ++h) { m[h] = -1e30f; l[h] = 0.f; acc[h] = 0.f; }
        for (int i = 0; i < ni; ++i) {
            const int s = lane + 64 * i;
            attn_batch<4>(zb + ZC_CK, zb + ZC_CV, NZ, s, ((selbits >> i) & 1u) != 0u && s <= t, t - s, 4, qs, bt, m, l, acc, lane);
        }
#pragma unroll
        for (int h = 0; h < 4; ++h) MIX[(size_t)it * D + MIX_C + h * 64 + lane] = f2bf(acc[h] / fmaxf(l[h], 1e-30f));
    }
}

__device__ __forceinline__ void nsa_compress_naive(const bf16_t* Z, const float* pos, const float* w1, const float* w2, bf16_t* KV, float* lds) {
    float* in = lds; float* hid = lds + 8 * 2048;
    const int tid = threadIdx.x;
    const int ngroups = (BATCH * NCMP) / 8;
    for (int item = blockIdx.x; item < 2 * ngroups; item += gridDim.x) {
        const int which = item / ngroups, g = item % ngroups;
        const int zc = which == 0 ? ZC_DKC : ZC_DVC;
        __syncthreads();
        for (int e = tid; e < 8 * 2048; e += 512) {
            const int rr = e >> 11, k = e & 2047, r = g * 8 + rr, b = r / NCMP, c = r % NCMP, p = k >> 6, d = k & 63;
            in[e] = bf2f(Z[((size_t)b * SEQ + 16 * c + p) * NZ + zc + d]) + pos[which * 2048 + k];
        }
        __syncthreads();
        {
            const int j = tid & 255, rh = tid >> 8;
            const float* w = w1 + (size_t)which * 2048 * 256 + j;
            float a0 = 0.f, a1 = 0.f, a2 = 0.f, a3 = 0.f;
            const float* i0 = in + (rh * 4) * 2048;
            for (int k = 0; k < 2048; ++k) {
                const float ww = w[(size_t)k * 256];
                a0 += i0[k] * ww; a1 += i0[2048 + k] * ww; a2 += i0[4096 + k] * ww; a3 += i0[6144 + k] * ww;
            }
            hid[(rh * 4 + 0) * 256 + j] = siluf_(a0); hid[(rh * 4 + 1) * 256 + j] = siluf_(a1);
            hid[(rh * 4 + 2) * 256 + j] = siluf_(a2); hid[(rh * 4 + 3) * 256 + j] = siluf_(a3);
        }
        __syncthreads();
        {
            const int rr = tid >> 6, d = tid & 63, r = g * 8 + rr, b = r / NCMP, c = r % NCMP;
            const float* w = w2 + (size_t)which * 256 * 64 + d;
            float a = 0.f;
            for (int j = 0; j < 256; ++j) a += hid[rr * 256 + j] * w[j * 64];
            KV[(size_t)which * BATCH * 128 * 64 + ((size_t)b * 128 + c) * 64 + d] = f2bf(a);
        }
    }
}

__device__ __forceinline__ void mixer_d_naive(const bf16_t* Z, const float* ZS, const bf16_t* KV, bf16_t* MIX, const float* bt, float* qs_all, float* ps_all) {
    const int lane = threadIdx.x & 63, wv = threadIdx.x >> 6, gw = blockIdx.x * 8 + wv, NGW = gridDim.x * 8;
    float* qs = qs_all + wv * 256; float* ps = ps_all + wv * 136 + 4;
    for (int it0 = gw; it0 < M; it0 += NGW) {
        const int b = it0 / SEQ; int t = it0 % SEQ; t = (t & 1) ? (SEQ - 1 - (t >> 1)) : (t >> 1);
        const int it = b * SEQ + t;
        const bf16_t* zb = Z + (size_t)b * SEQ * NZ;
#pragma unroll
        for (int h = 0; h < 4; ++h) qs[h * 64 + lane] = bf2f(zb[(size_t)t * NZ + ZC_DQ + h * 64 + lane]);
        const bf16_t* kc = KV + (size_t)b * 128 * 64; const bf16_t* vc = KV + (size_t)BATCH * 128 * 64 + (size_t)b * 128 * 64;
        const int nc = t >= 31 ? (t - 31) / 16 + 1 : 0;
        float lg[2][4]; float oc[4];
#pragma unroll
        for (int h = 0; h < 4; ++h) oc[h] = 0.f;
        float psum[2] = {0.f, 0.f};
        if (nc > 0) {
#pragma unroll
            for (int i = 0; i < 2; ++i) {
                const int c = lane + 64 * i;
#pragma unroll
                for (int h = 0; h < 4; ++h) lg[i][h] = -1e30f;
                if (c < nc) {
                    float dot[4]; dot_row<4>(kc + (size_t)c * 64, qs, dot);
                    int dd = t - (16 * c + 31); dd = dd > 127 ? 127 : dd;
#pragma unroll
                    for (int h = 0; h < 4; ++h) lg[i][h] = dot[h] + bt[dd * 12 + 8 + h];
                }
            }
            float pn[2][4];
#pragma unroll
            for (int h = 0; h < 4; ++h) {
                const float mx = wave_max(fmaxf(lg[0][h], lg[1][h]));
                const float p0 = (lane < nc) ? exp2f(lg[0][h] - mx) : 0.f, p1 = (lane + 64 < nc) ? exp2f(lg[1][h] - mx) : 0.f;
                const float den = fmaxf(wave_sum(p0 + p1), 1e-30f);
                pn[0][h] = p0 / den; pn[1][h] = p1 / den;
                psum[0] += pn[0][h]; psum[1] += pn[1][h];
            }
            for (int c = 0; c < nc; ++c) {
                const float v = bf2f(vc[(size_t)c * 64 + lane]);
#pragma unroll
                for (int h = 0; h < 4; ++h) oc[h] += __shfl(c < 64 ? pn[0][h] : pn[1][h], c & 63) * v;
            }
        }
        ps[lane] = psum[0]; ps[64 + lane] = (lane + 64 < NCMP) ? psum[1] : 0.f; if (lane == 0) { ps[-1] = 0.f; ps[128] = 0.f; }
        __builtin_amdgcn_s_waitcnt(0); __builtin_amdgcn_wave_barrier();
        const int cur = t >> 6;
        float imp = -1e30f; bool adm = false;
        if (lane < 32) {
            const int j = lane;
            imp = 0.5f * ps[4 * j - 1] + ps[4 * j] + ps[4 * j + 1] + ps[4 * j + 2] + 0.5f * ps[4 * j + 3];
            if (j == 0 || j == cur || j == cur - 1) imp = 1e9f;
            adm = (64 * j <= t);
            if (!adm) imp = -1e30f;
        }
        int rank = 0;
#pragma unroll
        for (int jj = 0; jj < 32; ++jj) { const float o = __shfl(imp, jj); rank += (o > imp || (o == imp && jj < lane)) ? 1 : 0; }
        const unsigned selmask = (unsigned)__ballot(lane < 32 && adm && rank < 16);
        __builtin_amdgcn_wave_barrier();
        float m[4], l[4], acc[4];
#pragma unroll
        for (int h = 0; h < 4; ++h) { m[h] = -1e30f; l[h] = 0.f; acc[h] = 0.f; }
        for (int j = 0; j <= cur; ++j) {
            if (!((selmask >> j) & 1u)) continue;
            const int s = 64 * j + lane;
            attn_batch<4>(zb + ZC_DKS, zb + ZC_DVS, NZ, s, s <= t, t - s, 8, qs, bt, m, l, acc, lane);
        }
        float os[4];
#pragma unroll
        for (int h = 0; h < 4; ++h) { os[h] = acc[h] / fmaxf(l[h], 1e-30f); m[h] = -1e30f; l[h] = 0.f; acc[h] = 0.f; }
        for (int i = 0; i < 8; ++i) {
            const int dist = i * 64 + lane, s = t - dist;
            attn_batch<4>(zb + ZC_DKW, zb + ZC_DVW, NZ, s, s >= 0, dist, 8, qs, bt, m, l, acc, lane);
        }
#pragma unroll
        for (int h = 0; h < 4; ++h) {
            const float ow = acc[h] / fmaxf(l[h], 1e-30f);
            const float g0 = sigmoidf_(ZS[(size_t)it * 32 + 12 + 3 * h + 0]), g1 = sigmoidf_(ZS[(size_t)it * 32 + 12 + 3 * h + 1]), g2 = sigmoidf_(ZS[(size_t)it * 32 + 12 + 3 * h + 2]);
            MIX[(size_t)it * D + MIX_D + h * 64 + lane] = f2bf(g0 * oc[h] + g1 * os[h] + g2 * ow);
        }
    }
}

__device__ __forceinline__ float conv_silu(const bf16_t* zb, const float* cw, int t, int ch) {
    float a = 0.f;
#pragma unroll
    for (int j = 0; j < 4; ++j) { const int tt = t - 3 + j; if (tt >= 0) a += cw[j * 256 + ch] * bf2f(zb[(size_t)tt * NZ + ch]); }
    return siluf_(a);
}
__device__ __forceinline__ void mlstm_local(const bf16_t* Z, const float* ZS, const float* cw, float* U, float* usm, float* lds) {
    float* wk = lds;
    float* vv = lds + 2048;
    float* sm = lds + 2048 + 4096;
    const int tid = threadIdx.x, lane = tid & 63;
    for (int item = blockIdx.x; item < BATCH * NH * 32; item += gridDim.x) {
        const int b = item / 128, h = (item / 32) % 4, c = item % 32;
        const bf16_t* zb = Z + (size_t)b * SEQ * NZ;
        __syncthreads();
        if (tid < 64) {
            const int t = 64 * c + lane; const size_t row = (size_t)b * SEQ + t;
            const float f = ZS[row * 32 + 4 + h], ig = ZS[row * 32 + h];
            const float lf = fminf(f, 0.f) - log1pf(__expf(-fabsf(f)));
            float bb = lf;
#pragma unroll
            for (int o = 1; o < 64; o <<= 1) { const float n = __shfl_up(bb, o); if (lane >= o) bb += n; }
            const float bL = __shfl(bb, 63);
            const float g = bL - bb + ig;
            const float G = wave_max(g);
            sm[lane] = __expf(g - G);
            if (lane == 0) { usm[2048 * 32 + item] = G; usm[2048 * 32 + 2048 + item] = bL; }
        }
        __syncthreads();
        for (int e = tid; e < 64 * 32; e += 512) { const int s = e >> 5, d = e & 31; wk[e] = sm[s] * conv_silu(zb, cw, 64 * c + s, 128 + h * 32 + d) * 0.17677669529663687f; }
        for (int e = tid; e < 64 * 64; e += 512) { const int s = e >> 6, d = e & 63; vv[e] = bf2f(zb[(size_t)(64 * c + s) * NZ + ZC_AV + h * 64 + d]); }
        __syncthreads();
        {
            const int d = tid >> 4, e0 = (tid & 15) * 4;
            float a0 = 0.f, a1 = 0.f, a2 = 0.f, a3 = 0.f;
            for (int s = 0; s < 64; ++s) { const float k = wk[s * 32 + d]; a0 += k * vv[s * 64 + e0]; a1 += k * vv[s * 64 + e0 + 1]; a2 += k * vv[s * 64 + e0 + 2]; a3 += k * vv[s * 64 + e0 + 3]; }
            *(f32x4*)(U + (size_t)item * 2048 + d * 64 + e0) = (f32x4){a0, a1, a2, a3};
        }
        if (tid < 32) { float a = 0.f; for (int s = 0; s < 64; ++s) a += wk[s * 32 + tid]; usm[item * 32 + tid] = a; }
    }
}
__device__ __forceinline__ void mlstm_out(const bf16_t* Z, const float* ZS, const float* cw, const float* U, const float* usm, const float* norm_g, bf16_t* MIX, float* lds) {
    float* qv = lds;
    float* kv = qv + 2048;
    float* vv = kv + 2048;
    float* Cs = vv + 4096;
    float* sc = Cs + 2048;
    float* hb = sc + 4096;
    float* nv = hb + 4096;
    float* bb_s = nv + 32;
    float* ii_s = bb_s + 64;
    float* mt_s = ii_s + 64;
    float* wi_s = mt_s + 64;
    float* den_s = wi_s + 64;
    float* coef = den_s + 64;
    float* misc = coef + 32;
    const int tid = threadIdx.x, lane = tid & 63, wv = tid >> 6;
    for (int item = blockIdx.x; item < BATCH * NH * 32; item += gridDim.x) {
        const int b = item / 128, h = (item / 32) % 4, c = item % 32;
        const bf16_t* zb = Z + (size_t)b * SEQ * NZ;
        const int item0 = item - c;
        __syncthreads();
        if (tid < 64) {
            const int t = 64 * c + lane; const size_t row = (size_t)b * SEQ + t;
            const float f = ZS[row * 32 + 4 + h], ig = ZS[row * 32 + h];
            const float lf = fminf(f, 0.f) - log1pf(__expf(-fabsf(f)));
            float bb = lf;
#pragma unroll
            for (int o = 1; o < 64; o <<= 1) { const float n = __shfl_up(bb, o); if (lane >= o) bb += n; }
            bb_s[lane] = bb; ii_s[lane] = ig;
            float mc = 0.f;
            for (int j = 0; j < c; ++j) { const float G = usm[2048 * 32 + item0 + j], bL = usm[2048 * 32 + 2048 + item0 + j]; mc = fmaxf(bL + mc, G); }
            if (lane < 32) {
                float cf = 0.f;
                if (lane < c) { float sfx = 0.f; for (int q = lane + 1; q < c; ++q) sfx += usm[2048 * 32 + 2048 + item0 + q]; cf = __expf(usm[2048 * 32 + item0 + lane] + sfx - mc); }
                coef[lane] = cf;
            }
            if (lane == 0) misc[0] = mc;
        }
        for (int e = tid; e < 64 * 32; e += 512) { const int s = e >> 5, d = e & 31; qv[e] = conv_silu(zb, cw, 64 * c + s, h * 32 + d); kv[e] = conv_silu(zb, cw, 64 * c + s, 128 + h * 32 + d) * 0.17677669529663687f; }
        for (int e = tid; e < 64 * 64; e += 512) { const int s = e >> 6, d = e & 63; vv[e] = bf2f(zb[(size_t)(64 * c + s) * NZ + ZC_AV + h * 64 + d]); }
        __syncthreads();
        {
            f32x4 a = (f32x4){0.f, 0.f, 0.f, 0.f};
            for (int j = 0; j < c; ++j) a += coef[j] * *(const f32x4*)(U + (size_t)(item0 + j) * 2048 + tid * 4);
            *(f32x4*)(Cs + tid * 4) = a;
            if (tid < 32) { float n = 0.f; for (int j = 0; j < c; ++j) n += coef[j] * usm[(item0 + j) * 32 + tid]; nv[tid] = n; }
        }
        if (tid < 64) {
            const float mc = misc[0]; const float bt_ = bb_s[lane];
            float mx = -1e30f;
            for (int s = 0; s <= lane; ++s) mx = fmaxf(mx, bt_ - bb_s[s] + ii_s[s]);
            const float mt = fmaxf(bt_ + mc, mx);
            mt_s[lane] = mt; wi_s[lane] = __expf(bt_ + mc - mt);
        }
        __syncthreads();
        for (int e = tid; e < 4096; e += 512) {
            const int t = e >> 6, s = e & 63; float v = 0.f;
            if (s <= t) { float dt = 0.f; for (int d = 0; d < 32; ++d) dt += qv[t * 32 + d] * kv[s * 32 + d]; v = dt * __expf(bb_s[t] - bb_s[s] + ii_s[s] - mt_s[t]); }
            sc[e] = v;
        }
        __syncthreads();
        if (tid < 64) {
            float dn = 0.f; for (int s = 0; s < 64; ++s) dn += sc[tid * 64 + s];
            float qn = 0.f; for (int d = 0; d < 32; ++d) qn += qv[tid * 32 + d] * nv[d];
            dn += wi_s[tid] * qn;
            den_s[tid] = fmaxf(fabsf(dn), __expf(-mt_s[tid]));
        }
        __syncthreads();
        for (int e = tid; e < 4096; e += 512) {
            const int t = e >> 6, d = e & 63; float a = 0.f, qc = 0.f;
            for (int s = 0; s < 64; ++s) a += sc[t * 64 + s] * vv[s * 64 + d];
            for (int k = 0; k < 32; ++k) qc += qv[t * 32 + k] * Cs[k * 64 + d];
            const float hh = (a + wi_s[t] * qc) / den_s[t];
            const float og = bf2f(zb[(size_t)(64 * c + t) * NZ + ZC_AO + h * 64 + d]);
            hb[e] = sigmoidf_(og) * hh;
        }
        __syncthreads();
        for (int tt = wv; tt < 64; tt += 8) {
            const float v = hb[tt * 64 + lane];
            const float mu = wave_sum(v) * (1.f / 64.f); const float dv = v - mu;
            const float var = wave_sum(dv * dv) * (1.f / 64.f);
            MIX[((size_t)b * SEQ + 64 * c + tt) * D + MIX_A + h * 64 + lane] = f2bf(dv * rsqrtf(var + LN_EPS) * norm_g[h * 64 + lane]);
        }
    }
}

constexpr int LDS_BYTES = 147456;
constexpr int NPH_PRO = 1, NPH_LAYER = 8;
constexpr int NPHASES = NPH_PRO + DEPTH * NPH_LAYER;

__global__ void __launch_bounds__(512, 2) mega(Params p) {
    extern __shared__ __attribute__((aligned(16))) unsigned char lds_raw[];
    float* lds = (float*)lds_raw;
    cg::grid_group grid = cg::this_grid();
    unsigned char* ws = p.ws;
    bf16_t* WIN = (bf16_t*)(ws + WS_WIN); bf16_t* WOUT = (bf16_t*)(ws + WS_WOUT); bf16_t* WFF1 = (bf16_t*)(ws + WS_WFF1); bf16_t* WFF2 = (bf16_t*)(ws + WS_WFF2);
    float* BINP = (float*)(ws + WS_BINP); bf16_t* KV = (bf16_t*)(ws + WS_KCMP); float* MU = (float*)(ws + WS_MU); float* MSM = (float*)(ws + WS_MSM);
    float* ZS = (float*)(ws + WS_ZS); bf16_t* XB = (bf16_t*)(ws + WS_XB); bf16_t* X1 = (bf16_t*)(ws + WS_X1); bf16_t* Z = (bf16_t*)(ws + WS_Z);
    bf16_t* MIX = (bf16_t*)(ws + WS_MIX); bf16_t* HID = (bf16_t*)(ws + WS_HID); float* Y1 = (float*)(ws + WS_Y1);
    float* bt = lds;
    float* qs_all = lds + 2048;
    float* ps_all = lds + 2048 + 2048;
    float* big = lds + 8192;

#define PH_BEGIN(k) if (p.ph_lo < (k) && (k) < p.ph_hi) grid.sync(); if (p.ph_lo <= (k) && (k) < p.ph_hi)
    PH_BEGIN(0) {
#pragma unroll
        for (int l = 0; l < DEPTH; ++l) {
            int dummy = 0;
            transpose_convert<true>(p.w_in + (size_t)l * D * DIN, D, DIN, WIN + (size_t)l * NZ * D, NZ, big, 0, dummy);
            transpose_convert<false>(p.w_out + (size_t)l * D * D, D, D, WOUT + (size_t)l * D * D, D, big, 0, dummy);
            transpose_convert<false>(p.w_ff1 + (size_t)l * D * DFF, D, DFF, WFF1 + (size_t)l * DFF * D, DFF, big, 0, dummy);
            transpose_convert<false>(p.w_ff2 + (size_t)l * DFF * D, DFF, D, WFF2 + (size_t)l * D * DFF, D, big, 0, dummy);
        }
        for (int i = blockIdx.x * 512 + threadIdx.x; i < DEPTH * NZ; i += gridDim.x * 512) { const int l = i / NZ, n = i % NZ, o = orig_col(n); BINP[i] = o >= 0 ? p.b_in[l * DIN + o] : 0.f; }
        for (size_t i = (size_t)blockIdx.x * 512 + threadIdx.x; i < (size_t)M * D / 4; i += (size_t)gridDim.x * 512) {
            const f32x4 v = ((const f32x4*)p.x)[i]; uint2 o; o.x = pk2(v[0], v[1]); o.y = pk2(v[2], v[3]); ((uint2*)XB)[i] = o;
        }
    }
#define LAYER_BODY(l) { \
        const int pb = 1 + l * NPH_LAYER; \
        const float* resid = l == 0 ? p.x : p.out; \
        PH_BEGIN(pb + 0) { EpiIn e{Z, ZS, BINP + l * NZ}; gemm_simple(XB, WIN + (size_t)l * NZ * D, M, NZ, D, e); } \
        PH_BEGIN(pb + 1) { \
            fill_bias_table(bt, p.rel_bias); __syncthreads(); \
            mlstm_local(Z, ZS, p.a_conv + l * 4 * 256, MU, MSM, big); \
            __syncthreads(); \
            nsa_compress_naive(Z, p.cmp_pos + (size_t)l * 2 * 2048, p.cmp_w1 + (size_t)l * 2 * 2048 * 256, p.cmp_w2 + (size_t)l * 2 * 256 * 64, KV, big); \
            __syncthreads(); \
            mixer_b_naive(Z, MIX, bt, qs_all); \
            mixer_c_naive(Z, ZS, MIX, bt, qs_all, (unsigned*)big); \
        } \
        PH_BEGIN(pb + 2) { \
            fill_bias_table(bt, p.rel_bias); __syncthreads(); \
            mlstm_out(Z, ZS, p.a_conv + l * 4 * 256, MU, MSM, p.a_norm + l * 256, MIX, big); \
            __syncthreads(); \
            mixer_d_naive(Z, ZS, KV, MIX, bt, qs_all, ps_all); \
        } \
        PH_BEGIN(pb + 3) { EpiOut e{Y1, resid, p.b_out + l * D}; gemm_simple(MIX, WOUT + (size_t)l * D * D, M, D, D, e); } \
        PH_BEGIN(pb + 4) { ln_pass(Y1, p.ln1_g + l * D, p.ln1_b + l * D, nullptr, X1); } \
        PH_BEGIN(pb + 5) { EpiFF1 e{HID, p.b_ff1 + l * DFF}; gemm_simple(X1, WFF1 + (size_t)l * DFF * D, M, DFF, D, e); } \
        PH_BEGIN(pb + 6) { EpiFF2 e{p.out, X1, p.b_ff2 + l * D}; gemm_simple(HID, WFF2 + (size_t)l * D * DFF, M, D, DFF, e); } \
        PH_BEGIN(pb + 7) { ln_pass(p.out, p.ln2_g + l * D, p.ln2_b + l * D, p.out, XB); } \
    }
    LAYER_BODY(0)
    LAYER_BODY(1)
}

extern "C" void kernel_launch(void* const* d_in, const int* in_sizes, int n_in, void* d_out, int out_size, void* d_ws, size_t ws_size, hipStream_t stream) {
    static int grid = 0;
    if (grid == 0) {
        if (n_in != 19 || in_sizes[0] != M * D || out_size != M * D || ws_size < WS_END) {
            fprintf(stderr, "kernel_launch: unexpected shapes n_in %d in0 %d out %d ws %zu (need %zu)\n", n_in, n_in > 0 ? in_sizes[0] : -1, out_size, ws_size, (size_t)WS_END);
            grid = -1; return;
        }
        int dev = 0, cus = 0, per_cu = 0;
        hipGetDevice(&dev);
        hipDeviceGetAttribute(&cus, hipDeviceAttributeMultiprocessorCount, dev);
        hipFuncSetAttribute((const void*)mega, hipFuncAttributeMaxDynamicSharedMemorySize, LDS_BYTES);
        hipOccupancyMaxActiveBlocksPerMultiprocessor(&per_cu, (const void*)mega, 512, LDS_BYTES);
        if (per_cu < 1) { fprintf(stderr, "kernel_launch: occupancy query says %d blocks/CU\n", per_cu); per_cu = 1; }
        grid = cus;
        (void)hipGetLastError();
    }
    if (grid < 0) return;
    Params p{};
    const float** pp = (const float**)&p;
    for (int i = 0; i < 19; ++i) pp[i] = (const float*)d_in[i];
    p.out = (float*)d_out; p.ws = (unsigned char*)d_ws;
    p.ph_lo = 0; p.ph_hi = NPHASES;
    void* args[] = {&p};
    hipError_t e = hipLaunchCooperativeKernel((const void*)mega, dim3(grid), dim3(512), args, LDS_BYTES, stream);
    if (e != hipSuccess) fprintf(stderr, "cooperative launch failed: %s (grid %d)\n", hipGetErrorString(e), grid);
}
```

```cpp
#include <hip/hip_runtime.h>
#include <hip/hip_cooperative_groups.h>
#include <cstdio>
#include <cstdint>
namespace cg = cooperative_groups;

typedef unsigned short bf16_t;
typedef short bf16x8 __attribute__((ext_vector_type(8)));
typedef float f32x4 __attribute__((ext_vector_type(4)));

constexpr int D = 1024, BATCH = 16, SEQ = 2048, M = BATCH * SEQ, DEPTH = 2, NH = 4, HD = 64, DFF = 4096, DIN = 2904, NZ = 3072;
constexpr float LN_EPS = 1e-5f;
constexpr float ALPHA = 1.4142135623730951f;
constexpr float LOG2E = 1.4426950408889634f;
constexpr float C2 = 0.125f * LOG2E;
constexpr int ZC_AQ = 0, ZC_AK = 128, ZC_AV = 256, ZC_AO = 512, ZC_BQ = 768, ZC_BK = 1024, ZC_BV = 1280, ZC_CQ = 1536, ZC_CK = 1792, ZC_CV = 1856,
              ZC_CIQ = 1920, ZC_CIK = 2176, ZC_DQ = 2240, ZC_DKC = 2496, ZC_DVC = 2560, ZC_DKS = 2624, ZC_DVS = 2688, ZC_DKW = 2752, ZC_DVW = 2816, ZC_SM = 2880;
constexpr int MIX_A = 0, MIX_B = 256, MIX_C = 512, MIX_D = 768;
constexpr int NCMP = 127;

__host__ __device__ constexpr int orig_col(int n) {
    return n < 512 ? n : n < 2240 ? n + 8 : n < 2880 ? n + 12 : n < 2884 ? 512 + (n - 2880) : n < 2888 ? 516 + (n - 2884) : n < 2892 ? 2248 + (n - 2888) : n < 2904 ? n : -1;
}

constexpr size_t MiB = 1u << 20;
constexpr size_t WS_CTL = 0;
constexpr size_t WS_WIN = 1 * MiB;
constexpr size_t WS_WOUT = WS_WIN + 12 * MiB;
constexpr size_t WS_WFF1 = WS_WOUT + 4 * MiB;
constexpr size_t WS_WFF2 = WS_WFF1 + 16 * MiB;
constexpr size_t WS_BINP = WS_WFF2 + 16 * MiB;
constexpr size_t WS_KCMP = WS_BINP + 1 * MiB;
constexpr size_t WS_MU = WS_KCMP + 1 * MiB;
constexpr size_t WS_MSM = WS_MU + 16 * MiB;
constexpr size_t WS_ZS = WS_MSM + 1 * MiB;
constexpr size_t WS_XB = WS_ZS + 4 * MiB;
constexpr size_t WS_X1 = WS_XB + 64 * MiB;
constexpr size_t WS_Z = WS_X1 + 64 * MiB;
constexpr size_t WS_MIX = WS_Z + 192 * MiB;
constexpr size_t WS_END = WS_MIX + 64 * MiB;
constexpr size_t WS_HID = WS_Z;
constexpr size_t WS_Y1 = WS_Z;

struct Params {
    const float *x, *w_in, *b_in, *a_conv, *a_norm, *cmp_pos, *cmp_w1, *cmp_w2, *w_out, *b_out, *ln1_g, *ln1_b, *w_ff1, *b_ff1, *w_ff2, *b_ff2, *ln2_g, *ln2_b, *rel_bias;
    float* out; unsigned char* ws;
    int ph_lo, ph_hi;
};

__device__ __forceinline__ float bf2f(bf16_t u) { return __uint_as_float((unsigned)u << 16); }
__device__ __forceinline__ bf16_t f2bf(float f) { unsigned u = __float_as_uint(f); return (bf16_t)((u + 0x7fffu + ((u >> 16) & 1u)) >> 16); }
__device__ __forceinline__ unsigned pk2(float lo, float hi) { return (unsigned)f2bf(lo) | ((unsigned)f2bf(hi) << 16); }
__device__ __forceinline__ float wave_max(float v) {
#pragma unroll
    for (int o = 32; o; o >>= 1) v = fmaxf(v, __shfl_xor(v, o));
    return v;
}
__device__ __forceinline__ float wave_sum(float v) {
#pragma unroll
    for (int o = 32; o; o >>= 1) v += __shfl_xor(v, o);
    return v;
}
__device__ __forceinline__ float sigmoidf_(float x) { return 1.f / (1.f + __expf(-x)); }
__device__ __forceinline__ float siluf_(float x) { return x / (1.f + __expf(-x)); }

__device__ __forceinline__ int t5_bucket_small(int n) {
    if (n < 16) return n;
    int v = 16 + (int)(__logf((float)n * (1.f / 16.f)) * (16.f / 2.0794415416798357f));
    return v > 31 ? 31 : v;
}

__device__ __forceinline__ void fill_bias_table(float* bt, const float* rel_bias) {
    for (int i = threadIdx.x; i < 128 * 12; i += blockDim.x) {
        int d = i / 12, h = i % 12;
        int n = d, b;
        if (n < 16) b = n; else { float v = log2f((float)n * 0.0625f) * (16.f / 3.f); b = 16 + (int)v; if (b > 31) b = 31; }
        bt[i] = rel_bias[b * 12 + h] * LOG2E;
    }
}

template <bool PERM>
__device__ __forceinline__ void transpose_convert(const float* __restrict__ W, int K, int Nsrc, bf16_t* __restrict__ WT, int Ndst, float* tile, int item0, int& itemBase) {
    (void)item0;
    const int tilesK = K / 64, tilesN = Ndst / 64, nt = tilesK * tilesN;
    const int tid = threadIdx.x;
    for (int it = blockIdx.x; it < nt; it += gridDim.x) {
        const int k0 = (it / tilesN) * 64, n0 = (it % tilesN) * 64;
        __syncthreads();
        {
            const int nl = tid & 63, kq = tid >> 6;
            const int nsrc = PERM ? orig_col(n0 + nl) : (n0 + nl);
#pragma unroll
            for (int i = 0; i < 8; ++i) { const int kk = kq * 8 + i; tile[kk * 65 + nl] = (nsrc >= 0) ? W[(size_t)(k0 + kk) * Nsrc + nsrc] : 0.f; }
        }
        __syncthreads();
        {
            const int nl = tid >> 3, kc = tid & 7;
            uint4 o;
            o.x = pk2(tile[(kc * 8 + 0) * 65 + nl], tile[(kc * 8 + 1) * 65 + nl]);
            o.y = pk2(tile[(kc * 8 + 2) * 65 + nl], tile[(kc * 8 + 3) * 65 + nl]);
            o.z = pk2(tile[(kc * 8 + 4) * 65 + nl], tile[(kc * 8 + 5) * 65 + nl]);
            o.w = pk2(tile[(kc * 8 + 6) * 65 + nl], tile[(kc * 8 + 7) * 65 + nl]);
            *(uint4*)(WT + (size_t)(n0 + nl) * K + k0 + kc * 8) = o;
        }
    }
    (void)itemBase;
}

namespace pg8 {
#define PG8_LAS __attribute__((address_space(3)))
typedef unsigned short bf16_t;
typedef short bf16x8 __attribute__((ext_vector_type(8)));
typedef float f32x4 __attribute__((ext_vector_type(4)));
typedef unsigned u32x4 __attribute__((ext_vector_type(4)));
constexpr int BM = 256, BK = 64, HALF = 128, HTB = HALF * BK * 2  , STAGE_BYTES = 8 * HTB, NXCD = 8, WGM = 8;

__host__ __device__ __forceinline__ int lds_byte(int r, int c) { const int st = (r >> 4) * 2 + (c >> 5), rr = r & 15, cc = c & 31, ob = rr * 64 + cc * 2; return st * 1024 + (ob ^ (((ob >> 9) & 1) << 5)); }
__host__ __device__ __forceinline__ void stage_rc(int b, int& R, int& C) { const int st = b / 1024, sb = b % 1024, swz = sb ^ (((sb >> 9) & 1) << 5); R = (st >> 1) * 16 + swz / 64; C = (st & 1) * 32 + (swz % 64) / 2; }
__host__ __device__ __forceinline__ int perm32(int rho) { const int n = rho >> 4, i = rho & 15; return 8 * (i >> 2) + 4 * n + (i & 3); }

struct Unit { int pm, pn; };
struct Gemm { const bf16_t* A; const bf16_t* Bt; int M, N, K; };

struct StaticOrder {
    int nM, nN, nwg, G, c;
    __host__ __device__ void init(int M, int N, int G_, int c_) { nM = M / BM; nN = N / BM; nwg = nM * nN; G = G_; c = c_; }
    __host__ __device__ bool next(int i, Unit& u) const {
        const long L = (long)i * G + c; if (L >= nwg) return false;
        int wgid = (int)L; { const int q = nwg / NXCD, r = nwg % NXCD, xcd = wgid % NXCD, off = wgid / NXCD; wgid = (xcd < r ? xcd * (q + 1) : r * (q + 1) + (xcd - r) * q) + off; }
        const int nig = WGM * nN, gid = wgid / nig, fm = gid * WGM, gsz = (nM - fm) < WGM ? (nM - fm) : WGM;
        u.pm = fm + ((wgid % nig) % gsz); u.pn = (wgid % nig) / gsz; return true;
    }
    __device__ __forceinline__ void a_ready(const Unit&) const {}
    __device__ __forceinline__ void done(const Unit&) const {}
};

__device__ __forceinline__ unsigned cvt_pk_bf16(float lo, float hi) { unsigned r; asm volatile("v_cvt_pk_bf16_f32 %0, %1, %2" : "=v"(r) : "v"(lo), "v"(hi)); return r; }
typedef float f32x2 __attribute__((ext_vector_type(2)));
template <class Epi, class Sched, bool ALIGN_EPI = false, bool SP2 = false>
__device__ __forceinline__ void gemm_phase(PG8_LAS unsigned char* lds, const Gemm g, const Sched& S, const Epi& E) {
    const int tid = threadIdx.x, wid = __builtin_amdgcn_readfirstlane(tid >> 6), lane = tid & 63, wr = wid >> 2, wc = wid & 3, fr = lane & 15, fq = lane >> 4;
    const int K = g.K, nt = K / BK;
    unsigned voffA[2], voffB[2];
#pragma unroll
    for (int i = 0; i < 2; ++i) { int R, C; stage_rc(tid * 16 + i * 8192, R, C); const int Rb = Epi::PERM ? ((R & ~31) + perm32(R & 31)) : R;
        voffA[i] = (unsigned)(R * K + C) * 2u; voffB[i] = (unsigned)(Rb * K + C) * 2u; }
    const size_t kstep = (size_t)(BK * 2);
    const size_t hstep = (size_t)HALF * K * 2;
    const size_t tstep = 2 * hstep;
    const unsigned ldsw = (unsigned)wid * 1024u;
    const int aoff = lds_byte(wr * 64 + fr, fq * 8), boff = lds_byte(wc * 32 + fr, fq * 8);
#define PG8_SA(b, h) (((b) * 2 + (h)) * HTB)
#define PG8_SB(b, h) ((4 + (b) * 2 + (h)) * HTB)
#define PG8_STAGE(bufoff, gbase, voff) do { _Pragma("unroll") for (int _i = 0; _i < 2; ++_i) \
        __builtin_amdgcn_global_load_lds((const unsigned*)((const char*)(gbase) + (voff)[_i]), (PG8_LAS unsigned*)(lds + (bufoff) + ldsw + _i * 8192), 16, 0, 0); } while (0)
#define PG8_LDA(dst, b, h) do { _Pragma("unroll") for (int m = 0; m < 4; ++m) _Pragma("unroll") for (int k = 0; k < 2; ++k) dst[m][k] = *(const PG8_LAS bf16x8*)(lds + PG8_SA(b, h) + aoff + m * 2048 + k * 1024); } while (0)
#define PG8_LDB(dst, b, h) do { _Pragma("unroll") for (int n = 0; n < 2; ++n) _Pragma("unroll") for (int k = 0; k < 2; ++k) dst[n][k] = *(const PG8_LAS bf16x8*)(lds + PG8_SB(b, h) + boff + n * 2048 + k * 1024); } while (0)
#define PG8_MMA(ai, bj, At, Bt) do { __builtin_amdgcn_s_setprio(1); _Pragma("unroll") for (int m = 0; m < 4; ++m) _Pragma("unroll") for (int n = 0; n < 2; ++n) _Pragma("unroll") for (int k = 0; k < 2; ++k) \
        acc[ai][bj][m][n] = __builtin_amdgcn_mfma_f32_16x16x32_bf16(Bt[n][k], At[m][k], acc[ai][bj][m][n], 0, 0, 0); __builtin_amdgcn_s_setprio(0); } while (0)
#define PG8_WAIT_V(n) asm volatile("s_waitcnt vmcnt(" #n ")" ::: "memory")
#define PG8_WAIT_L(n) asm volatile("s_waitcnt lgkmcnt(" #n ")" ::: "memory")
#define PG8_BAR __builtin_amdgcn_s_barrier()
#define PG8_SCHED __builtin_amdgcn_sched_barrier(0)
    Unit cur, nxt; int ui = 0;
    if (!S.next(0, cur)) return;
    f32x4 acc[2][2][4][2];
#pragma unroll
    for (int a = 0; a < 2; ++a)
#pragma unroll
        for (int b = 0; b < 2; ++b)
#pragma unroll
            for (int m = 0; m < 4; ++m)
#pragma unroll
                for (int n = 0; n < 2; ++n) acc[a][b][m][n] = (f32x4){0.f, 0.f, 0.f, 0.f};
    bf16x8 At[4][2], B0[2][2], B1[2][2];
    const char* cA = (const char*)g.A + (size_t)cur.pm * tstep; const char* cB = (const char*)g.Bt + (size_t)cur.pn * tstep;
    S.a_ready(cur);
    if constexpr (SP2) {
        PG8_STAGE(PG8_SB(0, 0), cB, voffB); PG8_STAGE(PG8_SB(0, 1), cB + hstep, voffB); PG8_STAGE(PG8_SA(0, 0), cA, voffA); PG8_STAGE(PG8_SA(0, 1), cA + hstep, voffA);
        if (wr == 1) PG8_BAR;
        PG8_WAIT_V(2); PG8_BAR;
        PG8_STAGE(PG8_SB(1, 0), cB + kstep, voffB); PG8_STAGE(PG8_SA(1, 0), cA + kstep, voffA); PG8_STAGE(PG8_SB(1, 1), cB + hstep + kstep, voffB);
        PG8_WAIT_V(6); PG8_BAR;
    } else {
        PG8_STAGE(PG8_SB(0, 0), cB, voffB); PG8_STAGE(PG8_SA(0, 0), cA, voffA); PG8_STAGE(PG8_SB(0, 1), cB + hstep, voffB); PG8_STAGE(PG8_SA(0, 1), cA + hstep, voffA);
        if (wr == 1) PG8_BAR;
        PG8_WAIT_V(4); PG8_BAR;
        PG8_STAGE(PG8_SB(1, 0), cB + kstep, voffB); PG8_STAGE(PG8_SA(1, 0), cA + kstep, voffA); PG8_STAGE(PG8_SB(1, 1), cB + hstep + kstep, voffB);
        PG8_WAIT_V(6); PG8_BAR;
    }
    for (;;) {
        const bool has_next = S.next(ui + 1, nxt);
        const char* nA = has_next ? (const char*)g.A + (size_t)nxt.pm * tstep : cA; const char* nB = has_next ? (const char*)g.Bt + (size_t)nxt.pn * tstep : cB;
        for (int t = 0; t < nt; t += 2) {
            const bool last = (t == nt - 2);
            const char* a1 = cA + (size_t)(t + 1) * kstep;
            const char* a2 = last ? nA : cA + (size_t)(t + 2) * kstep; const char* b2 = last ? nB : cB + (size_t)(t + 2) * kstep;
            const char* a3 = a2 + kstep; const char* b3 = b2 + kstep;
            if (last && has_next) S.a_ready(nxt);
            if constexpr (SP2) {
            PG8_LDB(B0, 0, 0); PG8_LDB(B1, 0, 1); PG8_SCHED; PG8_LDA(At, 0, 0); PG8_STAGE(PG8_SA(1, 1), a1 + hstep, voffA);
            PG8_WAIT_V(8); PG8_WAIT_L(0); PG8_BAR; PG8_MMA(0, 0, At, B0); PG8_MMA(0, 1, At, B1); PG8_BAR; PG8_SCHED;
            PG8_LDA(At, 0, 1); PG8_STAGE(PG8_SB(0, 0), b2, voffB); PG8_STAGE(PG8_SB(0, 1), b2 + hstep, voffB); PG8_STAGE(PG8_SA(0, 0), a2, voffA);
            PG8_WAIT_V(8); PG8_WAIT_L(0); PG8_BAR; PG8_MMA(1, 0, At, B0); PG8_MMA(1, 1, At, B1); PG8_BAR; PG8_SCHED;
            PG8_LDB(B0, 1, 0); PG8_LDB(B1, 1, 1); PG8_SCHED; PG8_LDA(At, 1, 0); PG8_STAGE(PG8_SA(0, 1), a2 + hstep, voffA);
            PG8_WAIT_V(8); PG8_WAIT_L(0); PG8_BAR; PG8_MMA(0, 0, At, B0); PG8_MMA(0, 1, At, B1); PG8_BAR; PG8_SCHED;
            PG8_LDA(At, 1, 1); PG8_STAGE(PG8_SB(1, 0), b3, voffB); PG8_STAGE(PG8_SB(1, 1), b3 + hstep, voffB); PG8_STAGE(PG8_SA(1, 0), a3, voffA);
            PG8_WAIT_V(8); PG8_WAIT_L(0); PG8_BAR; PG8_MMA(1, 0, At, B0); PG8_MMA(1, 1, At, B1); PG8_BAR; PG8_SCHED;
            } else {
            PG8_LDB(B0, 0, 0); PG8_SCHED; PG8_LDA(At, 0, 0); PG8_STAGE(PG8_SA(1, 1), a1 + hstep, voffA);
            PG8_WAIT_L(8); PG8_BAR; PG8_WAIT_L(0); PG8_MMA(0, 0, At, B0); PG8_BAR; PG8_SCHED;
            PG8_LDB(B1, 0, 1); PG8_STAGE(PG8_SB(0, 0), b2, voffB);
            PG8_BAR; PG8_WAIT_L(0); PG8_MMA(0, 1, At, B1); PG8_BAR;
            PG8_LDA(At, 0, 1); PG8_STAGE(PG8_SA(0, 0), a2, voffA);
            PG8_BAR; PG8_WAIT_L(0); PG8_MMA(1, 0, At, B0); PG8_BAR; PG8_SCHED;
            PG8_STAGE(PG8_SB(0, 1), b2 + hstep, voffB);
            PG8_WAIT_V(6); PG8_BAR; PG8_MMA(1, 1, At, B1); PG8_BAR;
            PG8_LDB(B0, 1, 0); PG8_SCHED; PG8_LDA(At, 1, 0); PG8_STAGE(PG8_SA(0, 1), a2 + hstep, voffA);
            PG8_WAIT_L(8); PG8_BAR; PG8_WAIT_L(0); PG8_MMA(0, 0, At, B0); PG8_BAR; PG8_SCHED;
            PG8_LDB(B1, 1, 1); PG8_STAGE(PG8_SB(1, 0), b3, voffB);
            PG8_BAR; PG8_WAIT_L(0); PG8_MMA(0, 1, At, B1); PG8_BAR;
            PG8_LDA(At, 1, 1); PG8_STAGE(PG8_SA(1, 0), a3, voffA);
            PG8_BAR; PG8_WAIT_L(0); PG8_MMA(1, 0, At, B0); PG8_BAR; PG8_SCHED;
            PG8_STAGE(PG8_SB(1, 1), b3 + hstep, voffB);
            PG8_WAIT_V(6); PG8_BAR; PG8_MMA(1, 1, At, B1); PG8_BAR;
            }
        }
        if constexpr (ALIGN_EPI) { if (wr == 0) PG8_BAR; }
        if constexpr (!Epi::AFTER_DRAIN) { E(acc, cur, wr, wc, fr, fq); S.done(cur); }
        if (!has_next) break;
#pragma unroll
        for (int a = 0; a < 2; ++a)
#pragma unroll
            for (int b = 0; b < 2; ++b)
#pragma unroll
                for (int m = 0; m < 4; ++m)
#pragma unroll
                    for (int n = 0; n < 2; ++n) acc[a][b][m][n] = (f32x4){0.f, 0.f, 0.f, 0.f};
        cur = nxt; cA = nA; cB = nB; ++ui;
        if constexpr (ALIGN_EPI) { if (wr == 1) PG8_BAR; }
    }
    PG8_WAIT_V(0);
    if constexpr (!ALIGN_EPI) { if (wr == 0) PG8_BAR; }
    PG8_BAR;
    if constexpr (Epi::AFTER_DRAIN) { E.fused(acc, cur, wr, wc, fr, fq, lds, wid, lane); S.done(cur); }
#undef PG8_SA
#undef PG8_SB
#undef PG8_STAGE
#undef PG8_LDA
#undef PG8_LDB
#undef PG8_MMA
#undef PG8_WAIT_V
#undef PG8_WAIT_L
#undef PG8_BAR
#undef PG8_SCHED
}

constexpr float kAlpha = 1.4142135623730951f;
constexpr float kC2 = 0.125f * 1.4426950408889634f;
struct EpiZ {
    static constexpr bool PERM = true, AFTER_DRAIN = false;
    bf16_t* Z; float* ZS; const float* bias;
    __device__ __forceinline__ void operator()(const f32x4 (&acc)[2][2][4][2], const Unit& u, int wr, int wc, int fr, int fq) const {
        const int row0 = u.pm * BM + wr * 64 + fr, col0 = u.pn * BM + wc * 32 + 8 * fq;
#pragma unroll
        for (int bj = 0; bj < 2; ++bj) {
            const int c = col0 + bj * HALF;
            const f32x4 b0 = *(const f32x4*)(bias + c), b1 = *(const f32x4*)(bias + c + 4);
            const bool qc = (c >= 768 && c < 1024) || (c >= 1536 && c < 1792) || (c >= 2240 && c < 2496);
            const float sc = qc ? kC2 : 1.f;
            const bool small = (c >= 2880 && c < 2912);
#pragma unroll
            for (int ai = 0; ai < 2; ++ai)
#pragma unroll
                for (int m = 0; m < 4; ++m) {
                    const size_t row = (size_t)(row0 + ai * HALF + m * 16);
                    f32x4 v0 = acc[ai][bj][m][0] + b0, v1 = acc[ai][bj][m][1] + b1;
                    if (small) { *(f32x4*)(ZS + row * 32 + (c - 2880)) = v0; *(f32x4*)(ZS + row * 32 + (c - 2880) + 4) = v1; }
                    v0 = v0 * sc; v1 = v1 * sc;
                    u32x4 w; w.x = cvt_pk_bf16(v0[0], v0[1]); w.y = cvt_pk_bf16(v0[2], v0[3]); w.z = cvt_pk_bf16(v1[0], v1[1]); w.w = cvt_pk_bf16(v1[2], v1[3]);
                    *(u32x4*)(Z + row * 3072 + c) = w;
                }
        }
    }
};
struct EpiH {
    static constexpr bool PERM = true, AFTER_DRAIN = false;
    bf16_t* Hd; const float* bias;
    __device__ __forceinline__ void operator()(const f32x4 (&acc)[2][2][4][2], const Unit& u, int wr, int wc, int fr, int fq) const {
        const int row0 = u.pm * BM + wr * 64 + fr, col0 = u.pn * BM + wc * 32 + 8 * fq;
#pragma unroll
        for (int bj = 0; bj < 2; ++bj) {
            const int c = col0 + bj * HALF;
            const f32x4 b0 = *(const f32x4*)(bias + c), b1 = *(const f32x4*)(bias + c + 4);
#pragma unroll
            for (int ai = 0; ai < 2; ++ai)
#pragma unroll
                for (int m = 0; m < 4; ++m) {
                    const size_t row = (size_t)(row0 + ai * HALF + m * 16);
                    f32x4 v0 = acc[ai][bj][m][0] + b0, v1 = acc[ai][bj][m][1] + b1;
#pragma unroll
                    for (int i = 0; i < 4; ++i) { const float a = fmaxf(v0[i], 0.f), b = fmaxf(v1[i], 0.f); v0[i] = a * a; v1[i] = b * b; }
                    u32x4 w; w.x = cvt_pk_bf16(v0[0], v0[1]); w.y = cvt_pk_bf16(v0[2], v0[3]); w.z = cvt_pk_bf16(v1[0], v1[1]); w.w = cvt_pk_bf16(v1[2], v1[3]);
                    *(u32x4*)(Hd + row * 4096 + c) = w;
                }
        }
    }
};
struct EpiY {
    static constexpr bool PERM = false, AFTER_DRAIN = false;
    float* Y; const float* resF; const bf16_t* resB; const float* bias;
    __device__ __forceinline__ void operator()(const f32x4 (&acc)[2][2][4][2], const Unit& u, int wr, int wc, int fr, int fq) const {
        const int row0 = u.pm * BM + wr * 64 + fr, col0 = u.pn * BM + wc * 32 + 4 * fq;
#pragma unroll
        for (int bj = 0; bj < 2; ++bj)
#pragma unroll
            for (int n = 0; n < 2; ++n) {
                const int c = col0 + bj * HALF + n * 16;
                const f32x4 bv = *(const f32x4*)(bias + c);
#pragma unroll
                for (int ai = 0; ai < 2; ++ai)
#pragma unroll
                    for (int m = 0; m < 4; ++m) {
                        const size_t off = (size_t)(row0 + ai * HALF + m * 16) * 1024 + c;
                        f32x4 x;
                        if (resF) x = *(const f32x4*)(resF + off);
                        else { const uint2 xr = *(const uint2*)(resB + off); x[0] = __uint_as_float(xr.x << 16); x[1] = __uint_as_float(xr.x & 0xffff0000u); x[2] = __uint_as_float(xr.y << 16); x[3] = __uint_as_float(xr.y & 0xffff0000u); }
                        *(f32x4*)(Y + off) = x * kAlpha + acc[ai][bj][m][n] + bv;
                    }
            }
    }
};
}
#define PG8_SP2 true
#define PG8_ALIGN true

template <class Epi>
__device__ __forceinline__ void gemm_simple(const bf16_t* __restrict__ A, const bf16_t* __restrict__ Bt, int Mr, int N, int K, const Epi& epi) {
    const int wid = threadIdx.x >> 6, lane = threadIdx.x & 63, wm = wid >> 1, wn = wid & 1;
    const int tilesN = N / 128, ntiles = (Mr / 256) * tilesN;
    for (int t = blockIdx.x; t < ntiles; t += gridDim.x) {
        const int tm = t / tilesN, tn = t % tilesN;
        const int row0 = tm * 256 + wm * 64, col0 = tn * 128 + wn * 64;
        f32x4 acc[4][4];
#pragma unroll
        for (int i = 0; i < 4; ++i)
#pragma unroll
            for (int j = 0; j < 4; ++j) acc[i][j] = (f32x4){0.f, 0.f, 0.f, 0.f};
        const bf16_t* ap = A + (size_t)(row0 + (lane & 15)) * K + 8 * (lane >> 4);
        const bf16_t* bp = Bt + (size_t)(col0 + (lane & 15)) * K + 8 * (lane >> 4);
        for (int k0 = 0; k0 < K; k0 += 32) {
            bf16x8 a[4], b[4];
#pragma unroll
            for (int i = 0; i < 4; ++i) a[i] = *(const bf16x8*)(ap + (size_t)i * 16 * K + k0);
#pragma unroll
            for (int i = 0; i < 4; ++i) b[i] = *(const bf16x8*)(bp + (size_t)i * 16 * K + k0);
#pragma unroll
            for (int i = 0; i < 4; ++i)
#pragma unroll
                for (int j = 0; j < 4; ++j) acc[i][j] = __builtin_amdgcn_mfma_f32_16x16x32_bf16(b[j], a[i], acc[i][j], 0, 0, 0);
        }
#pragma unroll
        for (int i = 0; i < 4; ++i)
#pragma unroll
            for (int j = 0; j < 4; ++j) epi(row0 + i * 16 + (lane & 15), col0 + j * 16 + 4 * (lane >> 4), acc[i][j]);
    }
}

struct EpiIn {
    bf16_t* Z; float* ZS; const float* bias;
    __device__ __forceinline__ void operator()(int r, int c, f32x4 v) const {
        const f32x4 b = *(const f32x4*)(bias + c);
        v += b;
        if (c >= ZC_SM && c < ZC_SM + 32) *(f32x4*)(ZS + (size_t)r * 32 + (c - ZC_SM)) = v;
        const bool qc = (c >= ZC_BQ && c < ZC_BK) || (c >= ZC_CQ && c < ZC_CK) || (c >= ZC_DQ && c < ZC_DKC);
        if (qc) v *= C2;
        uint2 o; o.x = pk2(v[0], v[1]); o.y = pk2(v[2], v[3]);
        *(uint2*)(Z + (size_t)r * NZ + c) = o;
    }
};
struct EpiOut {
    float* Y; const float* res; const float* bias;
    __device__ __forceinline__ void operator()(int r, int c, f32x4 v) const {
        const f32x4 b = *(const f32x4*)(bias + c);
        const f32x4 x = *(const f32x4*)(res + (size_t)r * D + c);
        *(f32x4*)(Y + (size_t)r * D + c) = x * ALPHA + v + b;
    }
};
struct EpiFF1 {
    bf16_t* Hd; const float* bias;
    __device__ __forceinline__ void operator()(int r, int c, f32x4 v) const {
        const f32x4 b = *(const f32x4*)(bias + c);
        v += b;
#pragma unroll
        for (int i = 0; i < 4; ++i) { float t = fmaxf(v[i], 0.f); v[i] = t * t; }
        uint2 o; o.x = pk2(v[0], v[1]); o.y = pk2(v[2], v[3]);
        *(uint2*)(Hd + (size_t)r * DFF + c) = o;
    }
};
struct EpiFF2 {
    float* Y; const bf16_t* X1; const float* bias;
    __device__ __forceinline__ void operator()(int r, int c, f32x4 v) const {
        const f32x4 b = *(const f32x4*)(bias + c);
        const uint2 xr = *(const uint2*)(X1 + (size_t)r * D + c);
        f32x4 x; x[0] = bf2f((bf16_t)(xr.x & 0xffff)); x[1] = bf2f((bf16_t)(xr.x >> 16)); x[2] = bf2f((bf16_t)(xr.y & 0xffff)); x[3] = bf2f((bf16_t)(xr.y >> 16));
        *(f32x4*)(Y + (size_t)r * D + c) = x * ALPHA + v + b;
    }
};

__device__ __forceinline__ void ln_pass(const float* Y, const float* g, const float* b, float* outF, bf16_t* outB) {
    const int lane = threadIdx.x & 63, gw = blockIdx.x * 8 + (threadIdx.x >> 6), NGW = gridDim.x * 8;
    for (int m = gw; m < M; m += NGW) {
        const f32x4* yr = (const f32x4*)(Y + (size_t)m * D) + lane;
        f32x4 v[4]; float s = 0.f;
#pragma unroll
        for (int j = 0; j < 4; ++j) { v[j] = yr[64 * j]; s += (v[j][0] + v[j][1]) + (v[j][2] + v[j][3]); }
        const float mean = wave_sum(s) * (1.f / D); float s2 = 0.f;
#pragma unroll
        for (int j = 0; j < 4; ++j) { v[j] = v[j] - mean; s2 += (v[j][0] * v[j][0] + v[j][1] * v[j][1]) + (v[j][2] * v[j][2] + v[j][3] * v[j][3]); }
        const float rstd = rsqrtf(wave_sum(s2) * (1.f / D) + LN_EPS);
#pragma unroll
        for (int j = 0; j < 4; ++j) {
            const int c = 4 * lane + 256 * j;
            const f32x4 gg = *(const f32x4*)(g + c), bb = *(const f32x4*)(b + c);
            const f32x4 o = v[j] * rstd * gg + bb;
            if (outF) *(f32x4*)(outF + (size_t)m * D + c) = o;
            uint2 w; w.x = pk2(o[0], o[1]); w.y = pk2(o[2], o[3]);
            *(uint2*)(outB + (size_t)m * D + c) = w;
        }
    }
}

template <int NHH>
__device__ __forceinline__ void dot_row(const bf16_t* __restrict__ krow, const float* qs, float (&dot)[NHH]) {
#pragma unroll
    for (int h = 0; h < NHH; ++h) dot[h] = 0.f;
    const uint4* kr = (const uint4*)krow;
#pragma unroll
    for (int c8 = 0; c8 < 8; ++c8) {
        const uint4 kv = kr[c8];
        float kf[8];
        kf[0] = __uint_as_float(kv.x << 16); kf[1] = __uint_as_float(kv.x & 0xffff0000u);
        kf[2] = __uint_as_float(kv.y << 16); kf[3] = __uint_as_float(kv.y & 0xffff0000u);
        kf[4] = __uint_as_float(kv.z << 16); kf[5] = __uint_as_float(kv.z & 0xffff0000u);
        kf[6] = __uint_as_float(kv.w << 16); kf[7] = __uint_as_float(kv.w & 0xffff0000u);
#pragma unroll
        for (int h = 0; h < NHH; ++h)
#pragma unroll
            for (int j = 0; j < 8; ++j) dot[h] += kf[j] * qs[h * 64 + c8 * 8 + j];
    }
}

template <int NHH>
__device__ __forceinline__ void attn_batch(const bf16_t* __restrict__ Kp, const bf16_t* __restrict__ Vp, int pitch, int s, bool valid, int dist, int bh0,
                                           const float* qs, const float* bt, float (&m)[NHH], float (&l)[NHH], float (&acc)[NHH], int lane) {
    unsigned long long vm = __ballot(valid);
    if (vm == 0ull) return;
    float lg[NHH];
#pragma unroll
    for (int h = 0; h < NHH; ++h) lg[h] = -1e30f;
    if (valid) {
        float dot[NHH];
        dot_row<NHH>(Kp + (size_t)s * pitch, qs, dot);
        const int dd = dist > 127 ? 127 : dist;
#pragma unroll
        for (int h = 0; h < NHH; ++h) lg[h] = dot[h] + bt[dd * 12 + bh0 + h];
    }
    float p[NHH];
#pragma unroll
    for (int h = 0; h < NHH; ++h) {
        const float bm = wave_max(lg[h]);
        const float mn = fmaxf(m[h], bm);
        const float sc = exp2f(m[h] - mn);
        p[h] = valid ? exp2f(lg[h] - mn) : 0.f;
        l[h] = l[h] * sc + wave_sum(p[h]);
        acc[h] *= sc; m[h] = mn;
    }
    while (vm) {
        const int kk = __ffsll((long long)vm) - 1; vm &= vm - 1;
        const int sk = __shfl(s, kk);
        const float v = bf2f(Vp[(size_t)sk * pitch + lane]);
#pragma unroll
        for (int h = 0; h < NHH; ++h) acc[h] += __shfl(p[h], kk) * v;
    }
}

__device__ __forceinline__ void mixer_b_naive(const bf16_t* Z, bf16_t* MIX, const float* bt, float* qs_all) {
    const int lane = threadIdx.x & 63, wv = threadIdx.x >> 6, gw = blockIdx.x * 8 + wv, NGW = gridDim.x * 8;
    float* qs = qs_all + wv * 256;
    for (int it = gw; it < M; it += NGW) {
        const int b = it / SEQ, t = it % SEQ;
        const bf16_t* zb = Z + (size_t)b * SEQ * NZ;
        for (int h = 0; h < NH; ++h) {
            qs[lane] = bf2f(zb[(size_t)t * NZ + ZC_BQ + h * 64 + lane]);
            float m[1] = {-1e30f}, l[1] = {0.f}, acc[1] = {0.f};
            const bf16_t* Kp = zb + ZC_BK + h * 64; const bf16_t* Vp = zb + ZC_BV + h * 64;
#pragma unroll
            for (int br = 0; br < 3; ++br) {
                const int dil = br == 0 ? 1 : br == 1 ? 4 : 16;
                const int p = t / dil; const int J = p < 128 ? p : 128;
                for (int jb = 0; jb <= J; jb += 64) {
                    const int j = jb + lane;
                    attn_batch<1>(Kp, Vp, NZ, t - j * dil, j <= J, j * dil, h, qs, bt, m, l, acc, lane);
                }
            }
            MIX[(size_t)it * D + MIX_B + h * 64 + lane] = f2bf(acc[0] / fmaxf(l[0], 1e-30f));
        }
    }
}

__device__ __forceinline__ unsigned mono_key(float f) { unsigned u = __float_as_uint(f); return (u & 0x80000000u) ? ~u : (u | 0x80000000u); }

__device__ __forceinline__ void mixer_c_naive(const bf16_t* Z, const float* ZS, bf16_t* MIX, const float* bt, float* qs_all, unsigned* scl_all) {
    const int lane = threadIdx.x & 63, wv = threadIdx.x >> 6, gw = blockIdx.x * 8 + wv, NGW = gridDim.x * 8;
    float* qs = qs_all + wv * 256; unsigned* scl = scl_all + wv * 2048;
    for (int it0 = gw; it0 < M; it0 += NGW) {
        const int b = it0 / SEQ; int t = it0 % SEQ; t = (t & 1) ? (SEQ - 1 - (t >> 1)) : (t >> 1);
        const int it = b * SEQ + t;
        const bf16_t* zb = Z + (size_t)b * SEQ * NZ;
#pragma unroll
        for (int h = 0; h < 4; ++h) qs[h * 64 + lane] = bf2f(zb[(size_t)t * NZ + ZC_CIQ + h * 64 + lane]);
        float iw[4];
#pragma unroll
        for (int h = 0; h < 4; ++h) iw[h] = ZS[(size_t)it * 32 + 8 + h] * 0.0625f;
        const int ni = t / 64 + 1;
        for (int i = 0; i < ni; ++i) {
            const int s = lane + 64 * i;
            unsigned key = 0u;
            if (s <= t) {
                float dot[4];
                dot_row<4>(zb + (size_t)s * NZ + ZC_CIK, qs, dot);
                float sc = 0.f;
#pragma unroll
                for (int h = 0; h < 4; ++h) sc += fmaxf(dot[h], 0.f) * iw[h];
                if (sc == 0.f) sc = 0.f;
                key = mono_key(sc);
            }
            scl[i * 64 + lane] = key;
        }
        unsigned kreg[32];
#pragma unroll
        for (int i = 0; i < 32; ++i) kreg[i] = (i < ni) ? scl[i * 64 + lane] : 0u;
        unsigned selbits = 0u;
        if (t + 1 <= 256) {
#pragma unroll
            for (int i = 0; i < 32; ++i) if (i < ni && lane + 64 * i <= t) selbits |= 1u << i;
        } else {
            unsigned T = 0u;
            for (int bit = 31; bit >= 0; --bit) {
                const unsigned cand = T | (1u << bit);
                int cnt = 0;
#pragma unroll
                for (int i = 0; i < 32; ++i) if (i < ni) cnt += __popcll(__ballot(kreg[i] >= cand));
                if (cnt >= 256) T = cand;
            }
            int ngt = 0;
#pragma unroll
            for (int i = 0; i < 32; ++i) if (i < ni) ngt += __popcll(__ballot(kreg[i] > T));
            const int r = 256 - ngt; int run = 0;
            const unsigned long long lower = (1ull << lane) - 1ull;
#pragma unroll
            for (int i = 0; i < 32; ++i) if (i < ni) {
                const bool eq = kreg[i] == T;
                const unsigned long long em = __ballot(eq);
                const int pre = run + __popcll(em & lower);
                if (kreg[i] > T || (eq && pre < r)) selbits |= 1u << i;
                run += __popcll(em);
            }
        }
#pragma unroll
        for (int h = 0; h < 4; ++h) qs[h * 64 + lane] = bf2f(zb[(size_t)t * NZ + ZC_CQ + h * 64 + lane]);
        float m[4], l[4], acc[4];
#pragma unroll
        for (int h = 0; h < 4; ++h) { m[h] = -1e30f; l[h] = 0.f; acc[h] = 0.f; }
        for (int i = 0; i < ni; ++i) {
            const int s = lane + 64 * i;
            attn_batch<4>(zb + ZC_CK, zb + ZC_CV, NZ, s, ((selbits >> i) & 1u) != 0u && s <= t, t - s, 4, qs, bt, m, l, acc, lane);
        }
#pragma unroll
        for (int h = 0; h < 4; ++h) MIX[(size_t)it * D + MIX_C + h * 64 + lane] = f2bf(acc[h] / fmaxf(l[h], 1e-30f));
    }
}

__device__ __forceinline__ void nsa_compress_naive(const bf16_t* Z, const float* pos, const float* w1, const float* w2, bf16_t* KV, float* lds) {
    float* in = lds; float* hid = lds + 8 * 2048;
    const int tid = threadIdx.x;
    const int ngroups = (BATCH * NCMP) / 8;
    for (int item = blockIdx.x; item < 2 * ngroups; item += gridDim.x) {
        const int which = item / ngroups, g = item % ngroups;
        const int zc = which == 0 ? ZC_DKC : ZC_DVC;
        __syncthreads();
        for (int e = tid; e < 8 * 2048; e += 512) {
            const int rr = e >> 11, k = e & 2047, r = g * 8 + rr, b = r / NCMP, c = r % NCMP, p = k >> 6, d = k & 63;
            in[e] = bf2f(Z[((size_t)b * SEQ + 16 * c + p) * NZ + zc + d]) + pos[which * 2048 + k];
        }
        __syncthreads();
        {
            const int j = tid & 255, rh = tid >> 8;
            const float* w = w1 + (size_t)which * 2048 * 256 + j;
            float a0 = 0.f, a1 = 0.f, a2 = 0.f, a3 = 0.f;
            const float* i0 = in + (rh * 4) * 2048;
            for (int k = 0; k < 2048; ++k) {
                const float ww = w[(size_t)k * 256];
                a0 += i0[k] * ww; a1 += i0[2048 + k] * ww; a2 += i0[4096 + k] * ww; a3 += i0[6144 + k] * ww;
            }
            hid[(rh * 4 + 0) * 256 + j] = siluf_(a0); hid[(rh * 4 + 1) * 256 + j] = siluf_(a1);
            hid[(rh * 4 + 2) * 256 + j] = siluf_(a2); hid[(rh * 4 + 3) * 256 + j] = siluf_(a3);
        }
        __syncthreads();
        {
            const int rr = tid >> 6, d = tid & 63, r = g * 8 + rr, b = r / NCMP, c = r % NCMP;
            const float* w = w2 + (size_t)which * 256 * 64 + d;
            float a = 0.f;
            for (int j = 0; j < 256; ++j) a += hid[rr * 256 + j] * w[j * 64];
            KV[(size_t)which * BATCH * 128 * 64 + ((size_t)b * 128 + c) * 64 + d] = f2bf(a);
        }
    }
}

__device__ __forceinline__ void mixer_d_naive(const bf16_t* Z, const float* ZS, const bf16_t* KV, bf16_t* MIX, const float* bt, float* qs_all, float* ps_all) {
    const int lane = threadIdx.x & 63, wv = threadIdx.x >> 6, gw = blockIdx.x * 8 + wv, NGW = gridDim.x * 8;
    float* qs = qs_all + wv * 256; float* ps = ps_all + wv * 136 + 4;
    for (int it0 = gw; it0 < M; it0 += NGW) {
        const int b = it0 / SEQ; int t = it0 % SEQ; t = (t & 1) ? (SEQ - 1 - (t >> 1)) : (t >> 1);
        const int it = b * SEQ + t;
        const bf16_t* zb = Z + (size_t)b * SEQ * NZ;
#pragma unroll
        for (int h = 0; h < 4; ++h) qs[h * 64 + lane] = bf2f(zb[(size_t)t * NZ + ZC_DQ + h * 64 + lane]);
        const bf16_t* kc = KV + (size_t)b * 128 * 64; const bf16_t* vc = KV + (size_t)BATCH * 128 * 64 + (size_t)b * 128 * 64;
        const int nc = t >= 31 ? (t - 31) / 16 + 1 : 0;
        float lg[2][4]; float oc[4];
#pragma unroll
        for (int h = 0; h < 4; ++h) oc[h] = 0.f;
        float psum[2] = {0.f, 0.f};
        if (nc > 0) {
#pragma unroll
            for (int i = 0; i < 2; ++i) {
                const int c = lane + 64 * i;
#pragma unroll
                for (int h = 0; h < 4; ++h) lg[i][h] = -1e30f;
                if (c < nc) {
                    float dot[4]; dot_row<4>(kc + (size_t)c * 64, qs, dot);
                    int dd = t - (16 * c + 31); dd = dd > 127 ? 127 : dd;
#pragma unroll
                    for (int h = 0; h < 4; ++h) lg[i][h] = dot[h] + bt[dd * 12 + 8 + h];
                }
            }
            float pn[2][4];
#pragma unroll
            for (int h = 0; h < 4; ++h) {
                const float mx = wave_max(fmaxf(lg[0][h], lg[1][h]));
                const float p0 = (lane < nc) ? exp2f(lg[0][h] - mx) : 0.f, p1 = (lane + 64 < nc) ? exp2f(lg[1][h] - mx) : 0.f;
                const float den = fmaxf(wave_sum(p0 + p1), 1e-30f);
                pn[0][h] = p0 / den; pn[1][h] = p1 / den;
                psum[0] += pn[0][h]; psum[1] += pn[1][h];
            }
            for (int c = 0; c < nc; ++c) {
                const float v = bf2f(vc[(size_t)c * 64 + lane]);
#pragma unroll
                for (int h = 0; h < 4; ++h) oc[h] += __shfl(c < 64 ? pn[0][h] : pn[1][h], c & 63) * v;
            }
        }
        ps[lane] = psum[0]; ps[64 + lane] = (lane + 64 < NCMP) ? psum[1] : 0.f; if (lane == 0) { ps[-1] = 0.f; ps[128] = 0.f; }
        __builtin_amdgcn_s_waitcnt(0); __builtin_amdgcn_wave_barrier();
        const int cur = t >> 6;
        float imp = -1e30f; bool adm = false;
        if (lane < 32) {
            const int j = lane;
            imp = 0.5f * ps[4 * j - 1] + ps[4 * j] + ps[4 * j + 1] + ps[4 * j + 2] + 0.5f * ps[4 * j + 3];
            if (j == 0 || j == cur || j == cur - 1) imp = 1e9f;
            adm = (64 * j <= t);
            if (!adm) imp = -1e30f;
        }
        int rank = 0;
#pragma unroll
        for (int jj = 0; jj < 32; ++jj) { const float o = __shfl(imp, jj); rank += (o > imp || (o == imp && jj < lane)) ? 1 : 0; }
        const unsigned selmask = (unsigned)__ballot(lane < 32 && adm && rank < 16);
        __builtin_amdgcn_wave_barrier();
        float m[4], l[4], acc[4];
#pragma unroll
        for (int h = 0; h < 4; ++h) { m[h] = -1e30f; l[h] = 0.f; acc[h] = 0.f; }
        for (int j = 0; j <= cur; ++j) {
            if (!((selmask >> j) & 1u)) continue;
            const int s = 64 * j + lane;
            attn_batch<4>(zb + ZC_DKS, zb + ZC_DVS, NZ, s, s <= t, t - s, 8, qs, bt, m, l, acc, lane);
        }
        float os[4];
#pragma unroll
        for (int h = 0; h < 4; ++h) { os[h] = acc[h] / fmaxf(l[h], 1e-30f); m[h] = -1e30f; l[h] = 0.f; acc[h] = 0.f; }
        for (int i = 0; i < 8; ++i) {
            const int dist = i * 64 + lane, s = t - dist;
            attn_batch<4>(zb + ZC_DKW, zb + ZC_DVW, NZ, s, s >= 0, dist, 8, qs, bt, m, l, acc, lane);
        }
#pragma unroll
        for (int h = 0; h < 4; ++h) {
            const float ow = acc[h] / fmaxf(l[h], 1e-30f);
            const float g0 = sigmoidf_(ZS[(size_t)it * 32 + 12 + 3 * h + 0]), g1 = sigmoidf_(ZS[(size_t)it * 32 + 12 + 3 * h + 1]), g2 = sigmoidf_(ZS[(size_t)it * 32 + 12 + 3 * h + 2]);
            MIX[(size_t)it * D + MIX_D + h * 64 + lane] = f2bf(g0 * oc[h] + g1 * os[h] + g2 * ow);
        }
    }
}

__device__ __forceinline__ float conv_silu(const bf16_t* zb, const float* cw, int t, int ch) {
    float a = 0.f;
#pragma unroll
    for (int j = 0; j < 4; ++j) { const int tt = t - 3 + j; if (tt >= 0) a += cw[j * 256 + ch] * bf2f(zb[(size_t)tt * NZ + ch]); }
    return siluf_(a);
}
__device__ __forceinline__ void mlstm_local(const bf16_t* Z, const float* ZS, const float* cw, float* U, float* usm, float* lds) {
    float* wk = lds;
    float* vv = lds + 2048;
    float* sm = lds + 2048 + 4096;
    const int tid = threadIdx.x, lane = tid & 63;
    for (int item = blockIdx.x; item < BATCH * NH * 32; item += gridDim.x) {
        const int b = item / 128, h = (item / 32) % 4, c = item % 32;
        const bf16_t* zb = Z + (size_t)b * SEQ * NZ;
        __syncthreads();
        if (tid < 64) {
            const int t = 64 * c + lane; const size_t row = (size_t)b * SEQ + t;
            const float f = ZS[row * 32 + 4 + h], ig = ZS[row * 32 + h];
            const float lf = fminf(f, 0.f) - log1pf(__expf(-fabsf(f)));
            float bb = lf;
#pragma unroll
            for (int o = 1; o < 64; o <<= 1) { const float n = __shfl_up(bb, o); if (lane >= o) bb += n; }
            const float bL = __shfl(bb, 63);
            const float g = bL - bb + ig;
            const float G = wave_max(g);
            sm[lane] = __expf(g - G);
            if (lane == 0) { usm[2048 * 32 + item] = G; usm[2048 * 32 + 2048 + item] = bL; }
        }
        __syncthreads();
        for (int e = tid; e < 64 * 32; e += 512) { const int s = e >> 5, d = e & 31; wk[e] = sm[s] * conv_silu(zb, cw, 64 * c + s, 128 + h * 32 + d) * 0.17677669529663687f; }
        for (int e = tid; e < 64 * 64; e += 512) { const int s = e >> 6, d = e & 63; vv[e] = bf2f(zb[(size_t)(64 * c + s) * NZ + ZC_AV + h * 64 + d]); }
        __syncthreads();
        {
            const int d = tid >> 4, e0 = (tid & 15) * 4;
            float a0 = 0.f, a1 = 0.f, a2 = 0.f, a3 = 0.f;
            for (int s = 0; s < 64; ++s) { const float k = wk[s * 32 + d]; a0 += k * vv[s * 64 + e0]; a1 += k * vv[s * 64 + e0 + 1]; a2 += k * vv[s * 64 + e0 + 2]; a3 += k * vv[s * 64 + e0 + 3]; }
            *(f32x4*)(U + (size_t)item * 2048 + d * 64 + e0) = (f32x4){a0, a1, a2, a3};
        }
        if (tid < 32) { float a = 0.f; for (int s = 0; s < 64; ++s) a += wk[s * 32 + tid]; usm[item * 32 + tid] = a; }
    }
}
__device__ __forceinline__ void mlstm_out(const bf16_t* Z, const float* ZS, const float* cw, const float* U, const float* usm, const float* norm_g, bf16_t* MIX, float* lds) {
    float* qv = lds;
    float* kv = qv + 2048;
    float* vv = kv + 2048;
    float* Cs = vv + 4096;
    float* sc = Cs + 2048;
    float* hb = sc + 4096;
    float* nv = hb + 4096;
    float* bb_s = nv + 32;
    float* ii_s = bb_s + 64;
    float* mt_s = ii_s + 64;
    float* wi_s = mt_s + 64;
    float* den_s = wi_s + 64;
    float* coef = den_s + 64;
    float* misc = coef + 32;
    const int tid = threadIdx.x, lane = tid & 63, wv = tid >> 6;
    for (int item = blockIdx.x; item < BATCH * NH * 32; item += gridDim.x) {
        const int b = item / 128, h = (item / 32) % 4, c = item % 32;
        const bf16_t* zb = Z + (size_t)b * SEQ * NZ;
        const int item0 = item - c;
        __syncthreads();
        if (tid < 64) {
            const int t = 64 * c + lane; const size_t row = (size_t)b * SEQ + t;
            const float f = ZS[row * 32 + 4 + h], ig = ZS[row * 32 + h];
            const float lf = fminf(f, 0.f) - log1pf(__expf(-fabsf(f)));
            float bb = lf;
#pragma unroll
            for (int o = 1; o < 64; o <<= 1) { const float n = __shfl_up(bb, o); if (lane >= o) bb += n; }
            bb_s[lane] = bb; ii_s[lane] = ig;
            float mc = 0.f;
            for (int j = 0; j < c; ++j) { const float G = usm[2048 * 32 + item0 + j], bL = usm[2048 * 32 + 2048 + item0 + j]; mc = fmaxf(bL + mc, G); }
            if (lane < 32) {
                float cf = 0.f;
                if (lane < c) { float sfx = 0.f; for (int q = lane + 1; q < c; ++q) sfx += usm[2048 * 32 + 2048 + item0 + q]; cf = __expf(usm[2048 * 32 + item0 + lane] + sfx - mc); }
                coef[lane] = cf;
            }
            if (lane == 0) misc[0] = mc;
        }
        for (int e = tid; e < 64 * 32; e += 512) { const int s = e >> 5, d = e & 31; qv[e] = conv_silu(zb, cw, 64 * c + s, h * 32 + d); kv[e] = conv_silu(zb, cw, 64 * c + s, 128 + h * 32 + d) * 0.17677669529663687f; }
        for (int e = tid; e < 64 * 64; e += 512) { const int s = e >> 6, d = e & 63; vv[e] = bf2f(zb[(size_t)(64 * c + s) * NZ + ZC_AV + h * 64 + d]); }
        __syncthreads();
        {
            f32x4 a = (f32x4){0.f, 0.f, 0.f, 0.f};
            for (int j = 0; j < c; ++j) a += coef[j] * *(const f32x4*)(U + (size_t)(item0 + j) * 2048 + tid * 4);
            *(f32x4*)(Cs + tid * 4) = a;
            if (tid < 32) { float n = 0.f; for (int j = 0; j < c; ++j) n += coef[j] * usm[(item0 + j) * 32 + tid]; nv[tid] = n; }
        }
        if (tid < 64) {
            const float mc = misc[0]; const float bt_ = bb_s[lane];
            float mx = -1e30f;
            for (int s = 0; s <= lane; ++s) mx = fmaxf(mx, bt_ - bb_s[s] + ii_s[s]);
            const float mt = fmaxf(bt_ + mc, mx);
            mt_s[lane] = mt; wi_s[lane] = __expf(bt_ + mc - mt);
        }
        __syncthreads();
        for (int e = tid; e < 4096; e += 512) {
            const int t = e >> 6, s = e & 63; float v = 0.f;
            if (s <= t) { float dt = 0.f; for (int d = 0; d < 32; ++d) dt += qv[t * 32 + d] * kv[s * 32 + d]; v = dt * __expf(bb_s[t] - bb_s[s] + ii_s[s] - mt_s[t]); }
            sc[e] = v;
        }
        __syncthreads();
        if (tid < 64) {
            float dn = 0.f; for (int s = 0; s < 64; ++s) dn += sc[tid * 64 + s];
            float qn = 0.f; for (int d = 0; d < 32; ++d) qn += qv[tid * 32 + d] * nv[d];
            dn += wi_s[tid] * qn;
            den_s[tid] = fmaxf(fabsf(dn), __expf(-mt_s[tid]));
        }
        __syncthreads();
        for (int e = tid; e < 4096; e += 512) {
            const int t = e >> 6, d = e & 63; float a = 0.f, qc = 0.f;
            for (int s = 0; s < 64; ++s) a += sc[t * 64 + s] * vv[s * 64 + d];
            for (int k = 0; k < 32; ++k) qc += qv[t * 32 + k] * Cs[k * 64 + d];
            const float hh = (a + wi_s[t] * qc) / den_s[t];
            const float og = bf2f(zb[(size_t)(64 * c + t) * NZ + ZC_AO + h * 64 + d]);
            hb[e] = sigmoidf_(og) * hh;
        }
        __syncthreads();
        for (int tt = wv; tt < 64; tt += 8) {
            const float v = hb[tt * 64 + lane];
            const float mu = wave_sum(v) * (1.f / 64.f); const float dv = v - mu;
            const float var = wave_sum(dv * dv) * (1.f / 64.f);
            MIX[((size_t)b * SEQ + 64 * c + tt) * D + MIX_A + h * 64 + lane] = f2bf(dv * rsqrtf(var + LN_EPS) * norm_g[h * 64 + lane]);
        }
    }
}

typedef float f32x16 __attribute__((ext_vector_type(16)));
typedef short s16x4 __attribute__((ext_vector_type(4)));
#define LAS3 __attribute__((address_space(3)))
constexpr int KT_STRIDE = 144;
constexpr int KT_BYTES = 64 * KT_STRIDE, VT_BYTES = 64 * 128, STG_BYTES = KT_BYTES + VT_BYTES;
constexpr int FA_BT = 0, FA_FSC = 6144, FA_STG = 8192;
constexpr float FA_MINIT = -1.0e4f, FA_MASKED = -1.0e30f;

typedef float f32x2_t __attribute__((ext_vector_type(2))); typedef __bf16 bf16x2_t __attribute__((ext_vector_type(2)));
__device__ __forceinline__ unsigned cvtpk(float lo, float hi) { f32x2_t v = {lo, hi}; bf16x2_t b = __builtin_convertvector(v, bf16x2_t); return __builtin_bit_cast(unsigned, b); }
__device__ __forceinline__ bf16x8 pack8(const f32x16& x, int s8) {
    typedef unsigned u32x4_ __attribute__((ext_vector_type(4)));
    u32x4_ p; p[0] = cvtpk(x[s8], x[s8 + 1]); p[1] = cvtpk(x[s8 + 2], x[s8 + 3]); p[2] = cvtpk(x[s8 + 4], x[s8 + 5]); p[3] = cvtpk(x[s8 + 6], x[s8 + 7]);
    return __builtin_bit_cast(bf16x8, p);
}
__device__ __forceinline__ s16x4 tr_read16(const LAS3 unsigned char* p) {
    typedef short v4i16_t __attribute__((ext_vector_type(4)));
    return __builtin_bit_cast(s16x4, __builtin_amdgcn_ds_read_tr16_b64_v4i16((LAS3 v4i16_t*)p));
}
struct FAState { f32x16 o0, o1; float m, l; };
__device__ __forceinline__ void fa_init(FAState& st) {
#pragma unroll
    for (int r = 0; r < 16; ++r) { st.o0[r] = 0.f; st.o1[r] = 0.f; }
    st.m = FA_MINIT; st.l = 0.f;
}
typedef unsigned u32x4v __attribute__((ext_vector_type(4)));
template <int CPT> struct TileRegs { u32x4v k[CPT], v[CPT]; };
template <int CPT, class RowFn>
__device__ __forceinline__ void tile_load(TileRegs<CPT>& tr, const bf16_t* __restrict__ kbase, const bf16_t* __restrict__ vbase, int pitch, RowFn rowfn, int lt) {
#pragma unroll
    for (int c = 0; c < CPT; ++c) {
        const int idx = c * (512 / CPT) + lt, row = idx >> 3, ch = idx & 7;
        const long g = rowfn(row);
        if (g >= 0) { tr.k[c] = *(const u32x4v*)(kbase + g * pitch + ch * 8); tr.v[c] = *(const u32x4v*)(vbase + g * pitch + ch * 8); }
        else { tr.k[c] = (u32x4v){0u, 0u, 0u, 0u}; tr.v[c] = (u32x4v){0u, 0u, 0u, 0u}; }
    }
}
template <int CPT>
__device__ __forceinline__ void tile_store(const TileRegs<CPT>& tr, LAS3 unsigned char* stg, int lt) {
#pragma unroll
    for (int c = 0; c < CPT; ++c) {
        const int idx = c * (512 / CPT) + lt, row = idx >> 3, ch = idx & 7;
        *(LAS3 u32x4v*)(stg + row * KT_STRIDE + ch * 16) = tr.k[c];
        *(LAS3 u32x4v*)(stg + KT_BYTES + row * 128 + ((ch * 16) ^ (((row >> 1) & 1) << 6))) = tr.v[c];
    }
}
__device__ __forceinline__ void fa_scores(f32x16& p0, f32x16& p1, const bf16x8 (&qf)[4], const LAS3 unsigned char* stg, float cinit, int lane) {
    const int r32 = lane & 31, hi = lane >> 5;
#pragma unroll
    for (int r = 0; r < 16; ++r) { p0[r] = cinit; p1[r] = cinit; }
    const LAS3 unsigned char* kp = stg + r32 * KT_STRIDE + hi * 16;
#pragma unroll
    for (int ks = 0; ks < 4; ++ks) {
        const bf16x8 a0 = *(const LAS3 bf16x8*)(kp + ks * 32);
        const bf16x8 a1 = *(const LAS3 bf16x8*)(kp + 32 * KT_STRIDE + ks * 32);
        p0 = __builtin_amdgcn_mfma_f32_32x32x16_bf16(a0, qf[ks], p0, 0, 0, 0);
        p1 = __builtin_amdgcn_mfma_f32_32x32x16_bf16(a1, qf[ks], p1, 0, 0, 0);
    }
}
__device__ __forceinline__ void fa_pv(f32x16& o0, f32x16& o1, const f32x16& p0, const f32x16& p1, const LAS3 unsigned char* stg, int lane) {
    const int hi = lane >> 5;
    bf16x8 pa[4];
    pa[0] = pack8(p0, 0); pa[1] = pack8(p0, 8); pa[2] = pack8(p1, 0); pa[3] = pack8(p1, 8);
    const int i16 = lane & 15, dh = (lane >> 4) & 1;
    const LAS3 unsigned char* vb = stg + KT_BYTES + (4 * hi + (i16 >> 2)) * 128;
    const int colb = 32 * dh + 8 * (i16 & 3), sw = ((lane >> 3) & 1) << 6;
#pragma unroll
    for (int kk = 0; kk < 4; ++kk) {
        const LAS3 unsigned char* vk = vb + (16 * kk) * 128;
#pragma unroll
        for (int d0 = 0; d0 < 2; ++d0) {
            const int off = (64 * d0 + colb) ^ sw;
            const s16x4 lo = tr_read16(vk + off), hh = tr_read16(vk + 8 * 128 + off);
            const bf16x8 vf = __builtin_shufflevector(lo, hh, 0, 1, 2, 3, 4, 5, 6, 7);
            if (d0 == 0) o0 = __builtin_amdgcn_mfma_f32_32x32x16_bf16(pa[kk], vf, o0, 0, 0, 0);
            else o1 = __builtin_amdgcn_mfma_f32_32x32x16_bf16(pa[kk], vf, o1, 0, 0, 0);
        }
    }
}
template <class Fix>
__device__ __forceinline__ void fa_tile(FAState& st, const bf16x8 (&qf)[4], const LAS3 unsigned char* stg, float cinit, const Fix& fix, LAS3 float* fsc, int lane) {
    const int r32 = lane & 31, hi = lane >> 5;
    f32x16 p0, p1;
    fa_scores(p0, p1, qf, stg, cinit, lane);
    fix(p0, p1);
    float mx = fmaxf(p0[0], p1[0]);
#pragma unroll
    for (int r = 1; r < 16; ++r) mx = fmaxf(mx, fmaxf(p0[r], p1[r]));
    mx = fmaxf(mx, __shfl_xor(mx, 32));
    if (__any(mx > st.m)) {
        const float mn = fmaxf(st.m, mx), f = __builtin_amdgcn_exp2f(st.m - mn);
        st.l *= f; st.m = mn;
        fsc[r32] = f;
        __builtin_amdgcn_s_waitcnt(0xc07f);
        __builtin_amdgcn_wave_barrier();
#pragma unroll
        for (int r = 0; r < 16; ++r) { const float fr = fsc[(r & 3) + 8 * (r >> 2) + 4 * hi]; st.o0[r] *= fr; st.o1[r] *= fr; }
        __builtin_amdgcn_wave_barrier();
    }
    float ls = 0.f;
#pragma unroll
    for (int r = 0; r < 16; ++r) { p0[r] = __builtin_amdgcn_exp2f(p0[r] - st.m); p1[r] = __builtin_amdgcn_exp2f(p1[r] - st.m); ls += p0[r] + p1[r]; }
    st.l += ls;
    fa_pv(st.o0, st.o1, p0, p1, stg, lane);
}
__device__ __forceinline__ void fa_finish(FAState& st, LAS3 float* fsc, int lane) {
    const int r32 = lane & 31, hi = lane >> 5;
    const float lt = st.l + __shfl_xor(st.l, 32);
    fsc[r32] = 1.f / fmaxf(lt, 1e-30f);
    __builtin_amdgcn_s_waitcnt(0xc07f);
    __builtin_amdgcn_wave_barrier();
#pragma unroll
    for (int r = 0; r < 16; ++r) { const float fr = fsc[(r & 3) + 8 * (r >> 2) + 4 * hi]; st.o0[r] *= fr; st.o1[r] *= fr; }
    __builtin_amdgcn_wave_barrier();
}
__device__ __forceinline__ void fa_store_bf16(const f32x16& o0, const f32x16& o1, bf16_t* dst, int pitch, int lane) {
    const int r32 = lane & 31, hi = lane >> 5;
#pragma unroll
    for (int r = 0; r < 16; ++r) {
        const int q = (r & 3) + 8 * (r >> 2) + 4 * hi;
        dst[(size_t)q * pitch + r32] = f2bf(o0[r]); dst[(size_t)q * pitch + 32 + r32] = f2bf(o1[r]);
    }
}

constexpr int C_SCL = FA_STG + 2 * STG_BYTES;
constexpr int C_MASK = C_SCL + 8 * 2048 * 4;
constexpr int C_END = C_MASK + 64 * 32 * 8;
__device__ __forceinline__ void mixer_c_fast(const bf16_t* Z, const float* ZS, bf16_t* MIX, unsigned char* lds_gen) {
    LAS3 unsigned char* lds = (LAS3 unsigned char*)lds_gen;
    const LAS3 float* bt = (const LAS3 float*)(lds + FA_BT);
    const int tid = threadIdx.x, lane = tid & 63, w = tid >> 6, r32 = lane & 31, hi = lane >> 5;
    LAS3 float* fsc = (LAS3 float*)(lds + FA_FSC) + w * 32;
    LAS3 unsigned* scl = (LAS3 unsigned*)(lds + C_SCL);
    LAS3 unsigned long long* maskL = (LAS3 unsigned long long*)(lds + C_MASK);
    for (int item = blockIdx.x; item < BATCH * 32; item += gridDim.x) {
        const int b = item & 15, qt = item < 256 ? 31 - (item >> 4) : (item - 256) >> 4;
        const bf16_t* zb = Z + (size_t)b * SEQ * NZ;
        __syncthreads();
        for (int rd = 0; rd < 8; ++rd) {
            const int tq0 = 64 * qt + 8 * rd, nk32 = (tq0 + 7) / 32 + 1;
            bf16x8 af[4];
#pragma unroll
            for (int ks = 0; ks < 4; ++ks) af[ks] = *(const bf16x8*)(zb + (size_t)(tq0 + (r32 >> 2)) * NZ + ZC_CIQ + (r32 & 3) * 64 + 16 * ks + 8 * hi);
            f32x4 iwv[4];
#pragma unroll
            for (int i = 0; i < 4; ++i) iwv[i] = *(const f32x4*)(ZS + ((size_t)b * SEQ + tq0 + 2 * i + hi) * 32 + 8) * 0.0625f;
            for (int tile = w; tile < nk32; tile += 8) {
                f32x16 acc;
#pragma unroll
                for (int r = 0; r < 16; ++r) acc[r] = 0.f;
                const bf16_t* kr = zb + (size_t)(32 * tile + r32) * NZ + ZC_CIK + 8 * hi;
#pragma unroll
                for (int ks = 0; ks < 4; ++ks) acc = __builtin_amdgcn_mfma_f32_32x32x16_bf16(af[ks], *(const bf16x8*)(kr + 16 * ks), acc, 0, 0, 0);
                const int key = 32 * tile + r32;
#pragma unroll
                for (int i = 0; i < 4; ++i) {
                    float sc = 0.f;
#pragma unroll
                    for (int j = 0; j < 4; ++j) sc += fmaxf(acc[4 * i + j], 0.f) * iwv[i][j];
                    if (sc == 0.f) sc = 0.f;
                    const int tq = tq0 + 2 * i + hi;
                    scl[(2 * i + hi) * 2048 + key] = key <= tq ? mono_key(sc) : 0u;
                }
            }
            __syncthreads();
            {
                const int tq = tq0 + w, ni = tq / 64 + 1;
                unsigned kreg[32];
#pragma unroll
                for (int i = 0; i < 32; ++i) kreg[i] = (i < ni && lane + 64 * i <= tq) ? scl[w * 2048 + 64 * i + lane] : 0u;
                unsigned long long myword = 0ull;
                if (tq + 1 <= 256) {
#pragma unroll
                    for (int i = 0; i < 32; ++i) if (i < ni) { const unsigned long long m64 = __ballot(lane + 64 * i <= tq); if (lane == i) myword = m64; }
                } else {
                    unsigned T = 0u;
                    for (int bit = 31; bit >= 0; --bit) {
                        const unsigned cand = T | (1u << bit);
                        int cnt = 0;
#pragma unroll
                        for (int i = 0; i < 32; ++i) if (i < ni) cnt += __popcll(__ballot(kreg[i] >= cand));
                        if (cnt >= 256) { T = cand; if (cnt == 256) break; }
                    }
                    int ngt = 0;
#pragma unroll
                    for (int i = 0; i < 32; ++i) if (i < ni) ngt += __popcll(__ballot(kreg[i] > T));
                    const int rr = 256 - ngt; int run = 0;
                    const unsigned long long lower = (1ull << lane) - 1ull;
#pragma unroll
                    for (int i = 0; i < 32; ++i) if (i < ni) {
                        const bool eq = kreg[i] == T;
                        const unsigned long long em = __ballot(eq);
                        const int pre = run + __popcll(em & lower);
                        const unsigned long long m64 = __ballot(kreg[i] > T || (eq && pre < rr));
                        if (lane == i) myword = m64;
                        run += __popcll(em);
                    }
                }
                if (lane < 32) maskL[(8 * rd + w) * 32 + lane] = myword;
            }
            __syncthreads();
        }
        {
            const int h = w & 3, sub = w >> 2, t0 = 64 * qt + 32 * sub, tq = t0 + r32;
            bf16x8 qf[4];
#pragma unroll
            for (int ks = 0; ks < 4; ++ks) qf[ks] = *(const bf16x8*)(zb + (size_t)tq * NZ + ZC_CQ + h * 64 + 16 * ks + 8 * hi);
            FAState st; fa_init(st);
            TileRegs<1> tr;
            const bf16_t* kb = zb + ZC_CK; const bf16_t* vb = zb + ZC_CV;
            tile_load<1>(tr, kb, vb, NZ, [&](int row) { return (long)row; }, tid);
            tile_store<1>(tr, lds + FA_STG, tid);
            __syncthreads();
            for (int kt = 0; kt <= qt; ++kt) {
                const int s0 = 64 * kt;
                if (kt < qt) tile_load<1>(tr, kb, vb, NZ, [&](int row) { return (long)(s0 + 64 + row); }, tid);
                const unsigned long long w64 = maskL[(32 * sub + r32) * 32 + kt];
                if (__any(w64 != 0ull)) {
                    const bool near = (t0 - (s0 + 63)) < 113;
                    const float cinit = near ? 0.f : bt[127 * 12 + 4 + h];
                    const unsigned wl = (unsigned)w64 >> (4 * hi), wh = (unsigned)(w64 >> 32) >> (4 * hi);
                    auto fix = [&](f32x16& p0, f32x16& p1) {
#pragma unroll
                        for (int r = 0; r < 16; ++r) {
                            const int cp = (r & 3) + 8 * (r >> 2);
                            if (near) {
                                int d0_ = tq - (s0 + cp + 4 * hi); int d1_ = d0_ - 32;
                                d0_ = d0_ < 0 ? 0 : (d0_ > 127 ? 127 : d0_); d1_ = d1_ < 0 ? 0 : (d1_ > 127 ? 127 : d1_);
                                p0[r] += bt[d0_ * 12 + 4 + h]; p1[r] += bt[d1_ * 12 + 4 + h];
                            }
                            p0[r] = ((wl >> cp) & 1u) ? p0[r] : FA_MASKED; p1[r] = ((wh >> cp) & 1u) ? p1[r] : FA_MASKED;
                        }
                    };
                    fa_tile(st, qf, lds + FA_STG + (kt & 1) * STG_BYTES, cinit, fix, fsc, lane);
                }
                if (kt < qt) tile_store<1>(tr, lds + FA_STG + ((kt + 1) & 1) * STG_BYTES, tid);
                __syncthreads();
            }
            fa_finish(st, fsc, lane);
            fa_store_bf16(st.o0, st.o1, MIX + ((size_t)b * SEQ + t0) * D + MIX_C + h * 64, D, lane);
        }
    }
}

constexpr int D_SELM = 7168;
constexpr int D_GATE = FA_STG + 2 * STG_BYTES;
constexpr int D_IMPL = D_GATE + 64 * 12 * 4;
constexpr int D_IMPS = D_IMPL + 4 * 64 * 32 * 4;
constexpr int D_RES = D_IMPS + 64 * 32 * 4;
constexpr int D_END = D_RES + 8 * 32 * 64 * 4;
template <bool FIRST>
__device__ __forceinline__ void acc_gated(LAS3 float* resL, const f32x16& o0, const f32x16& o1, const LAS3 float* gate, int hi, int lane) {
#pragma unroll
    for (int r = 0; r < 16; ++r) {
        const float g = gate[((r & 3) + 8 * (r >> 2) + 4 * hi) * 12];
        if (FIRST) { resL[(2 * r) * 64 + lane] = g * o0[r]; resL[(2 * r + 1) * 64 + lane] = g * o1[r]; }
        else { resL[(2 * r) * 64 + lane] += g * o0[r]; resL[(2 * r + 1) * 64 + lane] += g * o1[r]; }
    }
}
__device__ __forceinline__ void mixer_d_fast(const bf16_t* Z, const float* ZS, const bf16_t* KV, bf16_t* MIX, unsigned char* lds_gen) {
    LAS3 unsigned char* lds = (LAS3 unsigned char*)lds_gen;
    const LAS3 float* bt = (const LAS3 float*)(lds + FA_BT);
    for (int item = blockIdx.x; item < BATCH * 32; item += gridDim.x) {
        int tid = threadIdx.x; asm volatile("" : "+v"(tid));
        const int lane = tid & 63, w = __builtin_amdgcn_readfirstlane(tid >> 6), r32 = lane & 31, hi = lane >> 5;
        LAS3 float* fsc = (LAS3 float*)(lds + FA_FSC) + w * 32;
        LAS3 unsigned* selm = (LAS3 unsigned*)(lds + D_SELM);
        LAS3 float* gate = (LAS3 float*)(lds + D_GATE);
        LAS3 float* impl = (LAS3 float*)(lds + D_IMPL);
        LAS3 float* imps = (LAS3 float*)(lds + D_IMPS);
        const int h = w & 3, sub = w >> 2;
        const int b = item & 15, qt = item < 256 ? 31 - (item >> 4) : (item - 256) >> 4;
        const bf16_t* zb = Z + (size_t)b * SEQ * NZ;
        const int t0 = 64 * qt + 32 * sub, tq = t0 + r32;
        __syncthreads();
        for (int e = tid; e < 64 * 12; e += 512) gate[e] = sigmoidf_(ZS[((size_t)b * SEQ + 64 * qt + e / 12) * 32 + 12 + e % 12]);
        bf16x8 qf[4];
#pragma unroll
        for (int ks = 0; ks < 4; ++ks) qf[ks] = *(const bf16x8*)(zb + (size_t)tq * NZ + ZC_DQ + h * 64 + 16 * ks + 8 * hi);
        LAS3 float* resL = (LAS3 float*)(lds + D_RES) + w * 2048;
        const LAS3 float* gbase = gate + (32 * sub) * 12 + 3 * h;
        TileRegs<1> tr;
        {
            const bf16_t* kc = KV + (size_t)b * 128 * 64; const bf16_t* vc = KV + (size_t)BATCH * 128 * 64 + (size_t)b * 128 * 64;
            const bool two = qt >= 16;
            tile_load<1>(tr, kc, vc, 64, [&](int row) { return (long)row; }, tid);
            tile_store<1>(tr, lds + FA_STG, tid);
            if (two) {
                tile_load<1>(tr, kc, vc, 64, [&](int row) { return row < 63 ? (long)(64 + row) : -1L; }, tid);
                tile_store<1>(tr, lds + FA_STG + STG_BYTES, tid);
            }
            __syncthreads();
            f32x16 p0, p1, p2, p3;
            fa_scores(p0, p1, qf, lds + FA_STG, 0.f, lane);
            if (two) fa_scores(p2, p3, qf, lds + FA_STG + STG_BYTES, 0.f, lane);
            float mx = FA_MASKED;
            auto fixc = [&](float v, int c) -> float {
                int dist = tq - (16 * c + 31);
                const bool valid = dist >= 0;
                dist = dist < 0 ? 0 : (dist > 127 ? 127 : dist);
                return valid ? v + bt[dist * 12 + 8 + h] : FA_MASKED;
            };
#pragma unroll
            for (int r = 0; r < 16; ++r) {
                const int c0 = (r & 3) + 8 * (r >> 2) + 4 * hi;
                p0[r] = fixc(p0[r], c0); p1[r] = fixc(p1[r], c0 + 32);
                if (two) { p2[r] = fixc(p2[r], c0 + 64); p3[r] = fixc(p3[r], c0 + 96); } else { p2[r] = FA_MASKED; p3[r] = FA_MASKED; }
                mx = fmaxf(fmaxf(mx, fmaxf(p0[r], p1[r])), fmaxf(p2[r], p3[r]));
            }
            mx = fmaxf(mx, __shfl_xor(mx, 32));
            if (mx < -1.0e29f) mx = 0.f;
            float ls = 0.f;
#pragma unroll
            for (int r = 0; r < 16; ++r) {
                p0[r] = __builtin_amdgcn_exp2f(p0[r] - mx); p1[r] = __builtin_amdgcn_exp2f(p1[r] - mx);
                p2[r] = __builtin_amdgcn_exp2f(p2[r] - mx); p3[r] = __builtin_amdgcn_exp2f(p3[r] - mx);
                ls += (p0[r] + p1[r]) + (p2[r] + p3[r]);
            }
            const float inv = 1.f / fmaxf(ls + __shfl_xor(ls, 32), 1e-30f);
            float bprev = 0.f;
#pragma unroll
            for (int gi = 0; gi < 16; ++gi) {
                const int rr = gi & 3, sel = gi >> 2;
                const f32x16& P = sel == 0 ? p0 : sel == 1 ? p1 : sel == 2 ? p2 : p3;
                const float Bc = 0.5f * P[4 * rr + 3] * inv;
                const float Ac = (P[4 * rr] + P[4 * rr + 1] + P[4 * rr + 2]) * inv + Bc;
                const float bp = __shfl_xor(Bc, 32);
                impl[(h * 64 + 32 * sub + r32) * 32 + 2 * gi + hi] = Ac + (hi ? bp : bprev);
                bprev = bp;
            }
            FAState sc; fa_init(sc); sc.l = ls;
            fa_pv(sc.o0, sc.o1, p0, p1, lds + FA_STG, lane);
            if (two) fa_pv(sc.o0, sc.o1, p2, p3, lds + FA_STG + STG_BYTES, lane);
            fa_finish(sc, fsc, lane);
            acc_gated<true>(resL, sc.o0, sc.o1, gbase + 0, hi, lane);
        }
        __syncthreads();
#pragma unroll
        for (int k = 0; k < 4; ++k) {
            const int pi = tid + 512 * k, q = pi >> 5, jj = pi & 31;
            float v = ((impl[(0 * 64 + q) * 32 + jj] + impl[(1 * 64 + q) * 32 + jj]) + impl[(2 * 64 + q) * 32 + jj]) + impl[(3 * 64 + q) * 32 + jj];
            if (jj == 0 || jj == qt || jj == qt - 1) v = 1e9f;
            if (jj > qt) v = -1e30f;
            imps[pi] = v;
        }
        __syncthreads();
#pragma unroll
        for (int k = 0; k < 4; ++k) {
            const int pi = tid + 512 * k, q = pi >> 5, jj = pi & 31;
            const float my = imps[pi]; int rank = 0;
#pragma unroll
            for (int j2 = 0; j2 < 32; ++j2) { const float o = imps[q * 32 + j2]; rank += (o > my || (o == my && j2 < jj)) ? 1 : 0; }
            const unsigned long long m64 = __ballot(jj <= qt && rank < 16);
            if (lane == 0) { selm[2 * w + 16 * k] = (unsigned)m64; selm[2 * w + 16 * k + 1] = (unsigned)(m64 >> 32); }
        }
        __syncthreads();
        {
            unsigned bm = selm[lane];
#pragma unroll
            for (int o = 32; o; o >>= 1) bm |= __shfl_xor(bm, o);
            bm = __builtin_amdgcn_readfirstlane(bm);
            const unsigned mysel = selm[32 * sub + r32];
            const bf16_t* kb = zb + ZC_DKS; const bf16_t* vb = zb + ZC_DVS;
            FAState st; fa_init(st);
            int j = __ffs(bm) - 1, idx = 0;
            tile_load<1>(tr, kb, vb, NZ, [&](int row) { return (long)(64 * j + row); }, tid);
            tile_store<1>(tr, lds + FA_STG, tid);
            __syncthreads();
            for (;;) {
                bm &= bm - 1;
                const int jn = bm ? __ffs(bm) - 1 : -1;
                if (jn >= 0) tile_load<1>(tr, kb, vb, NZ, [&](int row) { return (long)(64 * jn + row); }, tid);
                const bool on = (mysel >> j) & 1u;
                if (__any(on)) {
                    const int s0 = 64 * j;
                    const bool near = (t0 - (s0 + 63)) < 113;
                    const float cinit = near ? 0.f : bt[127 * 12 + 8 + h];
                    auto fix = [&](f32x16& p0, f32x16& p1) {
#pragma unroll
                        for (int r = 0; r < 16; ++r) {
                            const int cp = (r & 3) + 8 * (r >> 2) + 4 * hi;
                            const int d0_ = tq - (s0 + cp), d1_ = d0_ - 32;
                            if (near) {
                                const int e0 = d0_ < 0 ? 0 : (d0_ > 127 ? 127 : d0_), e1 = d1_ < 0 ? 0 : (d1_ > 127 ? 127 : d1_);
                                p0[r] += bt[e0 * 12 + 8 + h]; p1[r] += bt[e1 * 12 + 8 + h];
                            }
                            p0[r] = (on && d0_ >= 0) ? p0[r] : FA_MASKED; p1[r] = (on && d1_ >= 0) ? p1[r] : FA_MASKED;
                        }
                    };
                    fa_tile(st, qf, lds + FA_STG + (idx & 1) * STG_BYTES, cinit, fix, fsc, lane);
                }
                if (jn >= 0) tile_store<1>(tr, lds + FA_STG + ((idx + 1) & 1) * STG_BYTES, tid);
                __syncthreads();
                if (jn < 0) break;
                j = jn; ++idx;
            }
            fa_finish(st, fsc, lane);
            acc_gated<false>(resL, st.o0, st.o1, gbase + 1, hi, lane);
        }
        {
            const bf16_t* kb = zb + ZC_DKW; const bf16_t* vb = zb + ZC_DVW;
            FAState st; fa_init(st);
            const int k0 = qt > 8 ? qt - 8 : 0;
            tile_load<1>(tr, kb, vb, NZ, [&](int row) { return (long)(64 * k0 + row); }, tid);
            tile_store<1>(tr, lds + FA_STG, tid);
            __syncthreads();
            for (int kt = k0; kt <= qt; ++kt) {
                const int s0 = 64 * kt, idx = kt - k0;
                if (kt < qt) tile_load<1>(tr, kb, vb, NZ, [&](int row) { return (long)(s0 + 64 + row); }, tid);
                if (t0 - s0 < 512 + 63) {
                    const bool near = (t0 - (s0 + 63)) < 113;
                    const float cinit = near ? 0.f : bt[127 * 12 + 8 + h];
                    auto fix = [&](f32x16& p0, f32x16& p1) {
#pragma unroll
                        for (int r = 0; r < 16; ++r) {
                            const int cp = (r & 3) + 8 * (r >> 2) + 4 * hi;
                            const int d0_ = tq - (s0 + cp), d1_ = d0_ - 32;
                            if (near) {
                                const int e0 = d0_ < 0 ? 0 : (d0_ > 127 ? 127 : d0_), e1 = d1_ < 0 ? 0 : (d1_ > 127 ? 127 : d1_);
                                p0[r] += bt[e0 * 12 + 8 + h]; p1[r] += bt[e1 * 12 + 8 + h];
                            }
                            p0[r] = (d0_ >= 0 && d0_ < 512) ? p0[r] : FA_MASKED; p1[r] = (d1_ >= 0 && d1_ < 512) ? p1[r] : FA_MASKED;
                        }
                    };
                    fa_tile(st, qf, lds + FA_STG + (idx & 1) * STG_BYTES, cinit, fix, fsc, lane);
                }
                if (kt < qt) tile_store<1>(tr, lds + FA_STG + ((idx + 1) & 1) * STG_BYTES, tid);
                __syncthreads();
            }
            fa_finish(st, fsc, lane);
            const LAS3 float* g2 = gbase + 2;
#pragma unroll
            for (int r = 0; r < 16; ++r) {
                const float g = g2[((r & 3) + 8 * (r >> 2) + 4 * hi) * 12];
                st.o0[r] = resL[(2 * r) * 64 + lane] + g * st.o0[r]; st.o1[r] = resL[(2 * r + 1) * 64 + lane] + g * st.o1[r];
            }
            fa_store_bf16(st.o0, st.o1, MIX + ((size_t)b * SEQ + t0) * D + MIX_D + h * 64, D, lane);
        }
    }
}

__device__ __forceinline__ void mixer_b_fast(const bf16_t* Z, float* PBO, float* PBL, unsigned char* lds_gen) {
    LAS3 unsigned char* lds = (LAS3 unsigned char*)lds_gen;
    const LAS3 float* bt = (const LAS3 float*)(lds + FA_BT);
    for (int item = blockIdx.x; item < 1536; item += gridDim.x) {
        int tid = threadIdx.x; asm volatile("" : "+v"(tid));
        const int lane = tid & 63, w = __builtin_amdgcn_readfirstlane(tid >> 6), r32 = lane & 31, hi = lane >> 5;
        LAS3 float* fsc = (LAS3 float*)(lds + FA_FSC) + w * 32;
        const int strm = w >> 2, wv = w & 3, lt = tid & 255;
        const int bh = item & 63, lp = item >> 6, br = lp >> 3, k = 2 * (lp & 7) + strm;
        const int b = bh >> 2, h = bh & 3;
        const int dil = br == 0 ? 1 : br == 1 ? 4 : 16;
        const int res = br == 0 ? 0 : br == 1 ? (k >> 2) : k;
        const int n = br == 0 ? k : br == 1 ? (k & 3) : 0;
        const bf16_t* zb = Z + (size_t)b * SEQ * NZ;
        const bf16_t* kb = zb + ZC_BK + h * 64; const bf16_t* vb = zb + ZC_BV + h * 64;
        const int relq = 128 + 32 * wv + r32;
        const int tok = res + dil * (128 * n + 32 * wv + r32);
        bf16x8 qf[4];
#pragma unroll
        for (int ks = 0; ks < 4; ++ks) qf[ks] = *(const bf16x8*)(zb + (size_t)tok * NZ + ZC_BQ + h * 64 + 16 * ks + 8 * hi);
        FAState st; fa_init(st);
        LAS3 unsigned char* sbase = lds + FA_STG + strm * 2 * STG_BYTES;
        const int kt0 = n > 0 ? 0 : 2;
        TileRegs<2> tr;
        __syncthreads();
        tile_load<2>(tr, kb, vb, NZ, [&](int row) { return (long)(res + dil * (128 * (n - 1) + 64 * kt0 + row)); }, lt);
        tile_store<2>(tr, sbase + (kt0 & 1) * STG_BYTES, lt);
        __syncthreads();
        for (int kt = 0; kt < 4; ++kt) {
            const bool have = kt >= kt0, havenext = kt + 1 < 4 && kt + 1 > kt0;
            if (havenext) tile_load<2>(tr, kb, vb, NZ, [&](int row) { return (long)(res + dil * (128 * (n - 1) + 64 * (kt + 1) + row)); }, lt);
            if (have && kt >= (wv >> 1) && kt <= (wv >> 1) + 2) {
                const int relk0 = 64 * kt;
                const bool near = (128 + 32 * wv - (relk0 + 63)) * dil < 113;
                const float cinit = near ? 0.f : bt[127 * 12 + h];
                auto fix = [&](f32x16& p0, f32x16& p1) {
#pragma unroll
                    for (int r = 0; r < 16; ++r) {
                        const int cp = (r & 3) + 8 * (r >> 2) + 4 * hi;
                        const int j0 = relq - (relk0 + cp), j1 = j0 - 32;
                        if (near) {
                            int e0 = j0 * dil, e1 = j1 * dil;
                            e0 = e0 < 0 ? 0 : (e0 > 127 ? 127 : e0); e1 = e1 < 0 ? 0 : (e1 > 127 ? 127 : e1);
                            p0[r] += bt[e0 * 12 + h]; p1[r] += bt[e1 * 12 + h];
                        }
                        p0[r] = (j0 >= 0 && j0 <= 128) ? p0[r] : FA_MASKED; p1[r] = (j1 >= 0 && j1 <= 128) ? p1[r] : FA_MASKED;
                    }
                };
                fa_tile(st, qf, sbase + (kt & 1) * STG_BYTES, cinit, fix, fsc, lane);
            }
            if (havenext) tile_store<2>(tr, sbase + ((kt + 1) & 1) * STG_BYTES, lt);
            __syncthreads();
        }
        const float ltot = st.l + __shfl_xor(st.l, 32);
        if (hi == 0) PBL[((size_t)br * M + (size_t)b * SEQ + tok) * 4 + h] = st.m + log2f(fmaxf(ltot, 1e-30f));
        fa_finish(st, fsc, lane);
#pragma unroll
        for (int r = 0; r < 16; ++r) {
            const int q = (r & 3) + 8 * (r >> 2) + 4 * hi;
            const int tk = res + dil * (128 * n + 32 * wv + q);
            float* dst = PBO + (((size_t)br * M + (size_t)b * SEQ + tk) * 4 + h) * 64;
            dst[r32] = st.o0[r]; dst[32 + r32] = st.o1[r];
        }
    }
}
__device__ __forceinline__ void mixer_b_combine(const float* PBO, const float* PBL, bf16_t* MIX) {
    const int lane = threadIdx.x & 63, gw = blockIdx.x * 8 + (threadIdx.x >> 6), NGW = gridDim.x * 8;
    for (int it = gw; it < M * 4; it += NGW) {
        const float l0 = PBL[it], l1 = PBL[(size_t)M * 4 + it], l2 = PBL[(size_t)2 * M * 4 + it];
        const float mx = fmaxf(l0, fmaxf(l1, l2));
        const float w0 = exp2f(l0 - mx), w1 = exp2f(l1 - mx), w2 = exp2f(l2 - mx), inv = 1.f / (w0 + w1 + w2);
        const float o = w0 * PBO[(size_t)it * 64 + lane] + w1 * PBO[((size_t)M * 4 + it) * 64 + lane] + w2 * PBO[((size_t)2 * M * 4 + it) * 64 + lane];
        MIX[(size_t)(it >> 2) * D + MIX_B + (it & 3) * 64 + lane] = f2bf(o * inv);
    }
}

constexpr int LDS_BYTES = 163840;
constexpr int NPH_PRO = 1, NPH_LAYER = 8;
constexpr int NPHASES = NPH_PRO + DEPTH * NPH_LAYER;

__global__ void __launch_bounds__(512, 2) mega(Params p) {
    extern __shared__ __attribute__((aligned(16))) unsigned char lds_raw[];
    float* lds = (float*)lds_raw;
    PG8_LAS unsigned char* glds = (PG8_LAS unsigned char*)lds_raw;
    cg::grid_group grid = cg::this_grid();
    unsigned char* ws = p.ws;
    bf16_t* WIN = (bf16_t*)(ws + WS_WIN); bf16_t* WOUT = (bf16_t*)(ws + WS_WOUT); bf16_t* WFF1 = (bf16_t*)(ws + WS_WFF1); bf16_t* WFF2 = (bf16_t*)(ws + WS_WFF2);
    float* BINP = (float*)(ws + WS_BINP); bf16_t* KV = (bf16_t*)(ws + WS_KCMP); float* MU = (float*)(ws + WS_MU); float* MSM = (float*)(ws + WS_MSM);
    float* ZS = (float*)(ws + WS_ZS); bf16_t* XB = (bf16_t*)(ws + WS_XB); bf16_t* X1 = (bf16_t*)(ws + WS_X1); bf16_t* Z = (bf16_t*)(ws + WS_Z);
    float* PBO = (float*)(ws + WS_XB); float* PBL = (float*)(ws + WS_XB + 100 * MiB);
    bf16_t* MIX = (bf16_t*)(ws + WS_MIX); bf16_t* HID = (bf16_t*)(ws + WS_HID); float* Y1 = (float*)(ws + WS_Y1);
    float* bt = lds;
    float* qs_all = lds + 2048;
    float* ps_all = lds + 2048 + 2048;
    float* big = lds + 8192;

#define PH_BEGIN(k) if (p.ph_lo < (k) && (k) < p.ph_hi) grid.sync(); if (p.ph_lo <= (k) && (k) < p.ph_hi)
    PH_BEGIN(0) {
#pragma unroll
        for (int l = 0; l < DEPTH; ++l) {
            int dummy = 0;
            transpose_convert<true>(p.w_in + (size_t)l * D * DIN, D, DIN, WIN + (size_t)l * NZ * D, NZ, big, 0, dummy);
            transpose_convert<false>(p.w_out + (size_t)l * D * D, D, D, WOUT + (size_t)l * D * D, D, big, 0, dummy);
            transpose_convert<false>(p.w_ff1 + (size_t)l * D * DFF, D, DFF, WFF1 + (size_t)l * DFF * D, DFF, big, 0, dummy);
            transpose_convert<false>(p.w_ff2 + (size_t)l * DFF * D, DFF, D, WFF2 + (size_t)l * D * DFF, D, big, 0, dummy);
        }
        for (int i = blockIdx.x * 512 + threadIdx.x; i < DEPTH * NZ; i += gridDim.x * 512) { const int l = i / NZ, n = i % NZ, o = orig_col(n); BINP[i] = o >= 0 ? p.b_in[l * DIN + o] : 0.f; }
        for (size_t i = (size_t)blockIdx.x * 512 + threadIdx.x; i < (size_t)M * D / 4; i += (size_t)gridDim.x * 512) {
            const f32x4 v = ((const f32x4*)p.x)[i]; uint2 o; o.x = pk2(v[0], v[1]); o.y = pk2(v[2], v[3]); ((uint2*)XB)[i] = o;
        }
    }
#define LAYER_BODY(l) { \
        const int pb = 1 + l * NPH_LAYER; \
        const float* resid = l == 0 ? p.x : p.out; \
        PH_BEGIN(pb + 0) { pg8::Gemm g{XB, WIN + (size_t)l * NZ * D, M, NZ, D}; pg8::StaticOrder S; S.init(M, NZ, (int)gridDim.x, (int)blockIdx.x); pg8::EpiZ e{Z, ZS, BINP + l * NZ}; pg8::gemm_phase<pg8::EpiZ, pg8::StaticOrder, PG8_ALIGN, PG8_SP2>(glds, g, S, e); } \
        PH_BEGIN(pb + 1) { \
            fill_bias_table(bt, p.rel_bias); __syncthreads(); \
            mlstm_local(Z, ZS, p.a_conv + l * 4 * 256, MU, MSM, big); \
            __syncthreads(); \
            nsa_compress_naive(Z, p.cmp_pos + (size_t)l * 2 * 2048, p.cmp_w1 + (size_t)l * 2 * 2048 * 256, p.cmp_w2 + (size_t)l * 2 * 256 * 64, KV, big); \
            __syncthreads(); \
            __syncthreads(); mixer_b_fast(Z, PBO, PBL, lds_raw); \
            __syncthreads(); mixer_c_fast(Z, ZS, MIX, lds_raw); \
        } \
        PH_BEGIN(pb + 2) { \
            fill_bias_table(bt, p.rel_bias); __syncthreads(); \
            mlstm_out(Z, ZS, p.a_conv + l * 4 * 256, MU, MSM, p.a_norm + l * 256, MIX, big); \
            __syncthreads(); \
            mixer_d_fast(Z, ZS, KV, MIX, lds_raw); \
            mixer_b_combine(PBO, PBL, MIX); \
        } \
        PH_BEGIN(pb + 3) { pg8::Gemm g{MIX, WOUT + (size_t)l * D * D, M, D, D}; pg8::StaticOrder S; S.init(M, D, (int)gridDim.x, (int)blockIdx.x); pg8::EpiY e{Y1, resid, nullptr, p.b_out + l * D}; pg8::gemm_phase<pg8::EpiY, pg8::StaticOrder, PG8_ALIGN, PG8_SP2>(glds, g, S, e); } \
        PH_BEGIN(pb + 4) { ln_pass(Y1, p.ln1_g + l * D, p.ln1_b + l * D, nullptr, X1); } \
        PH_BEGIN(pb + 5) { pg8::Gemm g{X1, WFF1 + (size_t)l * DFF * D, M, DFF, D}; pg8::StaticOrder S; S.init(M, DFF, (int)gridDim.x, (int)blockIdx.x); pg8::EpiH e{HID, p.b_ff1 + l * DFF}; pg8::gemm_phase<pg8::EpiH, pg8::StaticOrder, PG8_ALIGN, PG8_SP2>(glds, g, S, e); } \
        PH_BEGIN(pb + 6) { pg8::Gemm g{HID, WFF2 + (size_t)l * D * DFF, M, D, DFF}; pg8::StaticOrder S; S.init(M, D, (int)gridDim.x, (int)blockIdx.x); pg8::EpiY e{p.out, nullptr, X1, p.b_ff2 + l * D}; pg8::gemm_phase<pg8::EpiY, pg8::StaticOrder, PG8_ALIGN, PG8_SP2>(glds, g, S, e); } \
        PH_BEGIN(pb + 7) { ln_pass(p.out, p.ln2_g + l * D, p.ln2_b + l * D, p.out, XB); } \
    }
    LAYER_BODY(0)
    LAYER_BODY(1)
}

extern "C" void kernel_launch(void* const* d_in, const int* in_sizes, int n_in, void* d_out, int out_size, void* d_ws, size_t ws_size, hipStream_t stream) {
    static int grid = 0;
    if (grid == 0) {
        if (n_in != 19 || in_sizes[0] != M * D || out_size != M * D || ws_size < WS_END) {
            fprintf(stderr, "kernel_launch: unexpected shapes n_in %d in0 %d out %d ws %zu (need %zu)\n", n_in, n_in > 0 ? in_sizes[0] : -1, out_size, ws_size, (size_t)WS_END);
            grid = -1; return;
        }
        int dev = 0, cus = 0, per_cu = 0;
        hipGetDevice(&dev);
        hipDeviceGetAttribute(&cus, hipDeviceAttributeMultiprocessorCount, dev);
        hipFuncSetAttribute((const void*)mega, hipFuncAttributeMaxDynamicSharedMemorySize, LDS_BYTES);
        hipOccupancyMaxActiveBlocksPerMultiprocessor(&per_cu, (const void*)mega, 512, LDS_BYTES);
        if (per_cu < 1) { fprintf(stderr, "kernel_launch: occupancy query says %d blocks/CU\n", per_cu); per_cu = 1; }
        grid = cus;
        (void)hipGetLastError();
    }
    if (grid < 0) return;
    Params p{};
    const float** pp = (const float**)&p;
    for (int i = 0; i < 19; ++i) pp[i] = (const float*)d_in[i];
    p.out = (float*)d_out; p.ws = (unsigned char*)d_ws;
    p.ph_lo = 0; p.ph_hi = NPHASES;
    void* args[] = {&p};
    hipError_t e = hipLaunchCooperativeKernel((const void*)mega, dim3(grid), dim3(512), args, LDS_BYTES, stream);
    if (e != hipSuccess) fprintf(stderr, "cooperative launch failed: %s (grid %d)\n", hipGetErrorString(e), grid);
}
```

```cpp
#include <hip/hip_runtime.h>
#include <hip/hip_cooperative_groups.h>
#include <cstdio>
#include <cstdint>
namespace cg = cooperative_groups;

typedef unsigned short bf16_t;
typedef short bf16x8 __attribute__((ext_vector_type(8)));
typedef float f32x4 __attribute__((ext_vector_type(4)));

constexpr int D = 1024, BATCH = 16, SEQ = 2048, M = BATCH * SEQ, DEPTH = 2, NH = 4, HD = 64, DFF = 4096, DIN = 2904, NZ = 3072;
constexpr float LN_EPS = 1e-5f;
constexpr float ALPHA = 1.4142135623730951f;
constexpr float LOG2E = 1.4426950408889634f;
constexpr float C2 = 0.125f * LOG2E;
constexpr int ZC_AQ = 0, ZC_AK = 128, ZC_AV = 256, ZC_AO = 512, ZC_BQ = 768, ZC_BK = 1024, ZC_BV = 1280, ZC_CQ = 1536, ZC_CK = 1792, ZC_CV = 1856,
              ZC_CIQ = 1920, ZC_CIK = 2176, ZC_DQ = 2240, ZC_DKC = 2496, ZC_DVC = 2560, ZC_DKS = 2624, ZC_DVS = 2688, ZC_DKW = 2752, ZC_DVW = 2816, ZC_SM = 2880;
constexpr int MIX_A = 0, MIX_B = 256, MIX_C = 512, MIX_D = 768;
constexpr int NCMP = 127;

__host__ __device__ constexpr int orig_col(int n) {
    return n < 512 ? n : n < 2240 ? n + 8 : n < 2880 ? n + 12 : n < 2884 ? 512 + (n - 2880) : n < 2888 ? 516 + (n - 2884) : n < 2892 ? 2248 + (n - 2888) : n < 2904 ? n : -1;
}

constexpr size_t MiB = 1u << 20;
constexpr size_t WS_CTL = 0;
constexpr size_t WS_WIN = 1 * MiB;
constexpr size_t WS_WOUT = WS_WIN + 12 * MiB;
constexpr size_t WS_WFF1 = WS_WOUT + 4 * MiB;
constexpr size_t WS_WFF2 = WS_WFF1 + 16 * MiB;
constexpr size_t WS_BINP = WS_WFF2 + 16 * MiB;
constexpr size_t WS_KCMP = WS_BINP + 1 * MiB;
constexpr size_t WS_MU = WS_KCMP + 1 * MiB;
constexpr size_t WS_MSM = WS_MU + 16 * MiB;
constexpr size_t WS_ZS = WS_MSM + 1 * MiB;
constexpr size_t WS_XB = WS_ZS + 4 * MiB;
constexpr size_t WS_X1 = WS_XB + 64 * MiB;
constexpr size_t WS_Z = WS_X1 + 64 * MiB;
constexpr size_t WS_MIX = WS_Z + 192 * MiB;
constexpr size_t WS_CW1 = WS_MIX + 64 * MiB;
constexpr size_t WS_CW2 = WS_CW1 + 4 * MiB;
constexpr size_t WS_END = WS_CW2 + 1 * MiB;
constexpr size_t WS_HID = WS_Z;
constexpr size_t WS_Y1 = WS_Z;

struct Params {
    const float *x, *w_in, *b_in, *a_conv, *a_norm, *cmp_pos, *cmp_w1, *cmp_w2, *w_out, *b_out, *ln1_g, *ln1_b, *w_ff1, *b_ff1, *w_ff2, *b_ff2, *ln2_g, *ln2_b, *rel_bias;
    float* out; unsigned char* ws;
    int ph_lo, ph_hi;
};

__device__ __forceinline__ float bf2f(bf16_t u) { return __uint_as_float((unsigned)u << 16); }
__device__ __forceinline__ bf16_t f2bf(float f) { unsigned u = __float_as_uint(f); return (bf16_t)((u + 0x7fffu + ((u >> 16) & 1u)) >> 16); }
__device__ __forceinline__ unsigned pk2(float lo, float hi) { return (unsigned)f2bf(lo) | ((unsigned)f2bf(hi) << 16); }
__device__ __forceinline__ float wave_max(float v) {
#pragma unroll
    for (int o = 32; o; o >>= 1) v = fmaxf(v, __shfl_xor(v, o));
    return v;
}
__device__ __forceinline__ float wave_sum(float v) {
#pragma unroll
    for (int o = 32; o; o >>= 1) v += __shfl_xor(v, o);
    return v;
}
__device__ __forceinline__ float sigmoidf_(float x) { return 1.f / (1.f + __expf(-x)); }
__device__ __forceinline__ float siluf_(float x) { return x / (1.f + __expf(-x)); }

__device__ __forceinline__ int t5_bucket_small(int n) {
    if (n < 16) return n;
    int v = 16 + (int)(__logf((float)n * (1.f / 16.f)) * (16.f / 2.0794415416798357f));
    return v > 31 ? 31 : v;
}

__device__ __forceinline__ void fill_bias_table(float* bt, const float* rel_bias) {
    for (int i = threadIdx.x; i < 128 * 12; i += blockDim.x) {
        int d = i / 12, h = i % 12;
        int n = d, b;
        if (n < 16) b = n; else { float v = log2f((float)n * 0.0625f) * (16.f / 3.f); b = 16 + (int)v; if (b > 31) b = 31; }
        bt[i] = rel_bias[b * 12 + h] * LOG2E;
    }
}

template <bool PERM>
__device__ __forceinline__ void transpose_convert(const float* __restrict__ W, int K, int Nsrc, bf16_t* __restrict__ WT, int Ndst, float* tile, int item0, int& itemBase) {
    (void)item0;
    const int tilesK = K / 64, tilesN = Ndst / 64, nt = tilesK * tilesN;
    const int tid = threadIdx.x;
    for (int it = blockIdx.x; it < nt; it += gridDim.x) {
        const int k0 = (it / tilesN) * 64, n0 = (it % tilesN) * 64;
        __syncthreads();
        {
            const int nl = tid & 63, kq = tid >> 6;
            const int nsrc = PERM ? orig_col(n0 + nl) : (n0 + nl);
#pragma unroll
            for (int i = 0; i < 8; ++i) { const int kk = kq * 8 + i; tile[kk * 65 + nl] = (nsrc >= 0) ? W[(size_t)(k0 + kk) * Nsrc + nsrc] : 0.f; }
        }
        __syncthreads();
        {
            const int nl = tid >> 3, kc = tid & 7;
            uint4 o;
            o.x = pk2(tile[(kc * 8 + 0) * 65 + nl], tile[(kc * 8 + 1) * 65 + nl]);
            o.y = pk2(tile[(kc * 8 + 2) * 65 + nl], tile[(kc * 8 + 3) * 65 + nl]);
            o.z = pk2(tile[(kc * 8 + 4) * 65 + nl], tile[(kc * 8 + 5) * 65 + nl]);
            o.w = pk2(tile[(kc * 8 + 6) * 65 + nl], tile[(kc * 8 + 7) * 65 + nl]);
            *(uint4*)(WT + (size_t)(n0 + nl) * K + k0 + kc * 8) = o;
        }
    }
    (void)itemBase;
}

namespace pg8 {
#define PG8_LAS __attribute__((address_space(3)))
typedef unsigned short bf16_t;
typedef short bf16x8 __attribute__((ext_vector_type(8)));
typedef float f32x4 __attribute__((ext_vector_type(4)));
typedef unsigned u32x4 __attribute__((ext_vector_type(4)));
constexpr int BM = 256, BK = 64, HALF = 128, HTB = HALF * BK * 2  , STAGE_BYTES = 8 * HTB, NXCD = 8, WGM = 8;

__host__ __device__ __forceinline__ int lds_byte(int r, int c) { const int st = (r >> 4) * 2 + (c >> 5), rr = r & 15, cc = c & 31, ob = rr * 64 + cc * 2; return st * 1024 + (ob ^ (((ob >> 9) & 1) << 5)); }
__host__ __device__ __forceinline__ void stage_rc(int b, int& R, int& C) { const int st = b / 1024, sb = b % 1024, swz = sb ^ (((sb >> 9) & 1) << 5); R = (st >> 1) * 16 + swz / 64; C = (st & 1) * 32 + (swz % 64) / 2; }
__host__ __device__ __forceinline__ int perm32(int rho) { const int n = rho >> 4, i = rho & 15; return 8 * (i >> 2) + 4 * n + (i & 3); }

struct Unit { int pm, pn; };
struct Gemm { const bf16_t* A; const bf16_t* Bt; int M, N, K; };

struct StaticOrder {
    int nM, nN, nwg, G, c;
    __host__ __device__ void init(int M, int N, int G_, int c_) { nM = M / BM; nN = N / BM; nwg = nM * nN; G = G_; c = c_; }
    __host__ __device__ bool next(int i, Unit& u) const {
        const long L = (long)i * G + c; if (L >= nwg) return false;
        int wgid = (int)L; { const int q = nwg / NXCD, r = nwg % NXCD, xcd = wgid % NXCD, off = wgid / NXCD; wgid = (xcd < r ? xcd * (q + 1) : r * (q + 1) + (xcd - r) * q) + off; }
        const int nig = WGM * nN, gid = wgid / nig, fm = gid * WGM, gsz = (nM - fm) < WGM ? (nM - fm) : WGM;
        u.pm = fm + ((wgid % nig) % gsz); u.pn = (wgid % nig) / gsz; return true;
    }
    __device__ __forceinline__ void a_ready(const Unit&) const {}
    __device__ __forceinline__ void done(const Unit&) const {}
};

__device__ __forceinline__ unsigned cvt_pk_bf16(float lo, float hi) { unsigned r; asm volatile("v_cvt_pk_bf16_f32 %0, %1, %2" : "=v"(r) : "v"(lo), "v"(hi)); return r; }
typedef float f32x2 __attribute__((ext_vector_type(2)));
template <class Epi, class Sched, bool ALIGN_EPI = false, bool SP2 = false>
__device__ __forceinline__ void gemm_phase(PG8_LAS unsigned char* lds, const Gemm g, const Sched& S, const Epi& E) {
    const int tid = threadIdx.x, wid = __builtin_amdgcn_readfirstlane(tid >> 6), lane = tid & 63, wr = wid >> 2, wc = wid & 3, fr = lane & 15, fq = lane >> 4;
    const int K = g.K, nt = K / BK;
    unsigned voffA[2], voffB[2];
#pragma unroll
    for (int i = 0; i < 2; ++i) { int R, C; stage_rc(tid * 16 + i * 8192, R, C); const int Rb = Epi::PERM ? ((R & ~31) + perm32(R & 31)) : R;
        voffA[i] = (unsigned)(R * K + C) * 2u; voffB[i] = (unsigned)(Rb * K + C) * 2u; }
    const size_t kstep = (size_t)(BK * 2);
    const size_t hstep = (size_t)HALF * K * 2;
    const size_t tstep = 2 * hstep;
    const unsigned ldsw = (unsigned)wid * 1024u;
    const int aoff = lds_byte(wr * 64 + fr, fq * 8), boff = lds_byte(wc * 32 + fr, fq * 8);
#define PG8_SA(b, h) (((b) * 2 + (h)) * HTB)
#define PG8_SB(b, h) ((4 + (b) * 2 + (h)) * HTB)
#define PG8_STAGE(bufoff, gbase, voff) do { _Pragma("unroll") for (int _i = 0; _i < 2; ++_i) \
        __builtin_amdgcn_global_load_lds((const unsigned*)((const char*)(gbase) + (voff)[_i]), (PG8_LAS unsigned*)(lds + (bufoff) + ldsw + _i * 8192), 16, 0, 0); } while (0)
#define PG8_LDA(dst, b, h) do { _Pragma("unroll") for (int m = 0; m < 4; ++m) _Pragma("unroll") for (int k = 0; k < 2; ++k) dst[m][k] = *(const PG8_LAS bf16x8*)(lds + PG8_SA(b, h) + aoff + m * 2048 + k * 1024); } while (0)
#define PG8_LDB(dst, b, h) do { _Pragma("unroll") for (int n = 0; n < 2; ++n) _Pragma("unroll") for (int k = 0; k < 2; ++k) dst[n][k] = *(const PG8_LAS bf16x8*)(lds + PG8_SB(b, h) + boff + n * 2048 + k * 1024); } while (0)
#define PG8_MMA(ai, bj, At, Bt) do { __builtin_amdgcn_s_setprio(1); _Pragma("unroll") for (int m = 0; m < 4; ++m) _Pragma("unroll") for (int n = 0; n < 2; ++n) _Pragma("unroll") for (int k = 0; k < 2; ++k) \
        acc[ai][bj][m][n] = __builtin_amdgcn_mfma_f32_16x16x32_bf16(Bt[n][k], At[m][k], acc[ai][bj][m][n], 0, 0, 0); __builtin_amdgcn_s_setprio(0); } while (0)
#define PG8_WAIT_V(n) asm volatile("s_waitcnt vmcnt(" #n ")" ::: "memory")
#define PG8_WAIT_L(n) asm volatile("s_waitcnt lgkmcnt(" #n ")" ::: "memory")
#define PG8_BAR __builtin_amdgcn_s_barrier()
#define PG8_SCHED __builtin_amdgcn_sched_barrier(0)
    Unit cur, nxt; int ui = 0;
    if (!S.next(0, cur)) return;
    f32x4 acc[2][2][4][2];
#pragma unroll
    for (int a = 0; a < 2; ++a)
#pragma unroll
        for (int b = 0; b < 2; ++b)
#pragma unroll
            for (int m = 0; m < 4; ++m)
#pragma unroll
                for (int n = 0; n < 2; ++n) acc[a][b][m][n] = (f32x4){0.f, 0.f, 0.f, 0.f};
    bf16x8 At[4][2], B0[2][2], B1[2][2];
    const char* cA = (const char*)g.A + (size_t)cur.pm * tstep; const char* cB = (const char*)g.Bt + (size_t)cur.pn * tstep;
    S.a_ready(cur);
    if constexpr (SP2) {
        PG8_STAGE(PG8_SB(0, 0), cB, voffB); PG8_STAGE(PG8_SB(0, 1), cB + hstep, voffB); PG8_STAGE(PG8_SA(0, 0), cA, voffA); PG8_STAGE(PG8_SA(0, 1), cA + hstep, voffA);
        if (wr == 1) PG8_BAR;
        PG8_WAIT_V(2); PG8_BAR;
        PG8_STAGE(PG8_SB(1, 0), cB + kstep, voffB); PG8_STAGE(PG8_SA(1, 0), cA + kstep, voffA); PG8_STAGE(PG8_SB(1, 1), cB + hstep + kstep, voffB);
        PG8_WAIT_V(6); PG8_BAR;
    } else {
        PG8_STAGE(PG8_SB(0, 0), cB, voffB); PG8_STAGE(PG8_SA(0, 0), cA, voffA); PG8_STAGE(PG8_SB(0, 1), cB + hstep, voffB); PG8_STAGE(PG8_SA(0, 1), cA + hstep, voffA);
        if (wr == 1) PG8_BAR;
        PG8_WAIT_V(4); PG8_BAR;
        PG8_STAGE(PG8_SB(1, 0), cB + kstep, voffB); PG8_STAGE(PG8_SA(1, 0), cA + kstep, voffA); PG8_STAGE(PG8_SB(1, 1), cB + hstep + kstep, voffB);
        PG8_WAIT_V(6); PG8_BAR;
    }
    for (;;) {
        const bool has_next = S.next(ui + 1, nxt);
        const char* nA = has_next ? (const char*)g.A + (size_t)nxt.pm * tstep : cA; const char* nB = has_next ? (const char*)g.Bt + (size_t)nxt.pn * tstep : cB;
        for (int t = 0; t < nt; t += 2) {
            const bool last = (t == nt - 2);
            const char* a1 = cA + (size_t)(t + 1) * kstep;
            const char* a2 = last ? nA : cA + (size_t)(t + 2) * kstep; const char* b2 = last ? nB : cB + (size_t)(t + 2) * kstep;
            const char* a3 = a2 + kstep; const char* b3 = b2 + kstep;
            if (last && has_next) S.a_ready(nxt);
            if constexpr (SP2) {
            PG8_LDB(B0, 0, 0); PG8_LDB(B1, 0, 1); PG8_SCHED; PG8_LDA(At, 0, 0); PG8_STAGE(PG8_SA(1, 1), a1 + hstep, voffA);
            PG8_WAIT_V(8); PG8_WAIT_L(0); PG8_BAR; PG8_MMA(0, 0, At, B0); PG8_MMA(0, 1, At, B1); PG8_BAR; PG8_SCHED;
            PG8_LDA(At, 0, 1); PG8_STAGE(PG8_SB(0, 0), b2, voffB); PG8_STAGE(PG8_SB(0, 1), b2 + hstep, voffB); PG8_STAGE(PG8_SA(0, 0), a2, voffA);
            PG8_WAIT_V(8); PG8_WAIT_L(0); PG8_BAR; PG8_MMA(1, 0, At, B0); PG8_MMA(1, 1, At, B1); PG8_BAR; PG8_SCHED;
            PG8_LDB(B0, 1, 0); PG8_LDB(B1, 1, 1); PG8_SCHED; PG8_LDA(At, 1, 0); PG8_STAGE(PG8_SA(0, 1), a2 + hstep, voffA);
            PG8_WAIT_V(8); PG8_WAIT_L(0); PG8_BAR; PG8_MMA(0, 0, At, B0); PG8_MMA(0, 1, At, B1); PG8_BAR; PG8_SCHED;
            PG8_LDA(At, 1, 1); PG8_STAGE(PG8_SB(1, 0), b3, voffB); PG8_STAGE(PG8_SB(1, 1), b3 + hstep, voffB); PG8_STAGE(PG8_SA(1, 0), a3, voffA);
            PG8_WAIT_V(8); PG8_WAIT_L(0); PG8_BAR; PG8_MMA(1, 0, At, B0); PG8_MMA(1, 1, At, B1); PG8_BAR; PG8_SCHED;
            } else {
            PG8_LDB(B0, 0, 0); PG8_SCHED; PG8_LDA(At, 0, 0); PG8_STAGE(PG8_SA(1, 1), a1 + hstep, voffA);
            PG8_WAIT_L(8); PG8_BAR; PG8_WAIT_L(0); PG8_MMA(0, 0, At, B0); PG8_BAR; PG8_SCHED;
            PG8_LDB(B1, 0, 1); PG8_STAGE(PG8_SB(0, 0), b2, voffB);
            PG8_BAR; PG8_WAIT_L(0); PG8_MMA(0, 1, At, B1); PG8_BAR;
            PG8_LDA(At, 0, 1); PG8_STAGE(PG8_SA(0, 0), a2, voffA);
            PG8_BAR; PG8_WAIT_L(0); PG8_MMA(1, 0, At, B0); PG8_BAR; PG8_SCHED;
            PG8_STAGE(PG8_SB(0, 1), b2 + hstep, voffB);
            PG8_WAIT_V(6); PG8_BAR; PG8_MMA(1, 1, At, B1); PG8_BAR;
            PG8_LDB(B0, 1, 0); PG8_SCHED; PG8_LDA(At, 1, 0); PG8_STAGE(PG8_SA(0, 1), a2 + hstep, voffA);
            PG8_WAIT_L(8); PG8_BAR; PG8_WAIT_L(0); PG8_MMA(0, 0, At, B0); PG8_BAR; PG8_SCHED;
            PG8_LDB(B1, 1, 1); PG8_STAGE(PG8_SB(1, 0), b3, voffB);
            PG8_BAR; PG8_WAIT_L(0); PG8_MMA(0, 1, At, B1); PG8_BAR;
            PG8_LDA(At, 1, 1); PG8_STAGE(PG8_SA(1, 0), a3, voffA);
            PG8_BAR; PG8_WAIT_L(0); PG8_MMA(1, 0, At, B0); PG8_BAR; PG8_SCHED;
            PG8_STAGE(PG8_SB(1, 1), b3 + hstep, voffB);
            PG8_WAIT_V(6); PG8_BAR; PG8_MMA(1, 1, At, B1); PG8_BAR;
            }
        }
        if constexpr (ALIGN_EPI) { if (wr == 0) PG8_BAR; }
        if constexpr (!Epi::AFTER_DRAIN) { E(acc, cur, wr, wc, fr, fq); S.done(cur); }
        if (!has_next) break;
#pragma unroll
        for (int a = 0; a < 2; ++a)
#pragma unroll
            for (int b = 0; b < 2; ++b)
#pragma unroll
                for (int m = 0; m < 4; ++m)
#pragma unroll
                    for (int n = 0; n < 2; ++n) acc[a][b][m][n] = (f32x4){0.f, 0.f, 0.f, 0.f};
        cur = nxt; cA = nA; cB = nB; ++ui;
        if constexpr (ALIGN_EPI) { if (wr == 1) PG8_BAR; }
    }
    PG8_WAIT_V(0);
    if constexpr (!ALIGN_EPI) { if (wr == 0) PG8_BAR; }
    PG8_BAR;
    if constexpr (Epi::AFTER_DRAIN) { E.fused(acc, cur, wr, wc, fr, fq, lds, wid, lane); S.done(cur); }
#undef PG8_SA
#undef PG8_SB
#undef PG8_STAGE
#undef PG8_LDA
#undef PG8_LDB
#undef PG8_MMA
#undef PG8_WAIT_V
#undef PG8_WAIT_L
#undef PG8_BAR
#undef PG8_SCHED
}

constexpr float kAlpha = 1.4142135623730951f;
constexpr float kC2 = 0.125f * 1.4426950408889634f;
struct EpiZ {
    static constexpr bool PERM = true, AFTER_DRAIN = false;
    bf16_t* Z; float* ZS; const float* bias;
    __device__ __forceinline__ void operator()(const f32x4 (&acc)[2][2][4][2], const Unit& u, int wr, int wc, int fr, int fq) const {
        const int row0 = u.pm * BM + wr * 64 + fr, col0 = u.pn * BM + wc * 32 + 8 * fq;
#pragma unroll
        for (int bj = 0; bj < 2; ++bj) {
            const int c = col0 + bj * HALF;
            const f32x4 b0 = *(const f32x4*)(bias + c), b1 = *(const f32x4*)(bias + c + 4);
            const bool qc = (c >= 768 && c < 1024) || (c >= 1536 && c < 1792) || (c >= 2240 && c < 2496);
            const float sc = qc ? kC2 : 1.f;
            const bool small = (c >= 2880 && c < 2912);
#pragma unroll
            for (int ai = 0; ai < 2; ++ai)
#pragma unroll
                for (int m = 0; m < 4; ++m) {
                    const size_t row = (size_t)(row0 + ai * HALF + m * 16);
                    f32x4 v0 = acc[ai][bj][m][0] + b0, v1 = acc[ai][bj][m][1] + b1;
                    if (small) { *(f32x4*)(ZS + row * 32 + (c - 2880)) = v0; *(f32x4*)(ZS + row * 32 + (c - 2880) + 4) = v1; }
                    v0 = v0 * sc; v1 = v1 * sc;
                    u32x4 w; w.x = cvt_pk_bf16(v0[0], v0[1]); w.y = cvt_pk_bf16(v0[2], v0[3]); w.z = cvt_pk_bf16(v1[0], v1[1]); w.w = cvt_pk_bf16(v1[2], v1[3]);
                    *(u32x4*)(Z + row * 3072 + c) = w;
                }
        }
    }
};
struct EpiH {
    static constexpr bool PERM = true, AFTER_DRAIN = false;
    bf16_t* Hd; const float* bias;
    __device__ __forceinline__ void operator()(const f32x4 (&acc)[2][2][4][2], const Unit& u, int wr, int wc, int fr, int fq) const {
        const int row0 = u.pm * BM + wr * 64 + fr, col0 = u.pn * BM + wc * 32 + 8 * fq;
#pragma unroll
        for (int bj = 0; bj < 2; ++bj) {
            const int c = col0 + bj * HALF;
            const f32x4 b0 = *(const f32x4*)(bias + c), b1 = *(const f32x4*)(bias + c + 4);
#pragma unroll
            for (int ai = 0; ai < 2; ++ai)
#pragma unroll
                for (int m = 0; m < 4; ++m) {
                    const size_t row = (size_t)(row0 + ai * HALF + m * 16);
                    f32x4 v0 = acc[ai][bj][m][0] + b0, v1 = acc[ai][bj][m][1] + b1;
#pragma unroll
                    for (int i = 0; i < 4; ++i) { const float a = fmaxf(v0[i], 0.f), b = fmaxf(v1[i], 0.f); v0[i] = a * a; v1[i] = b * b; }
                    u32x4 w; w.x = cvt_pk_bf16(v0[0], v0[1]); w.y = cvt_pk_bf16(v0[2], v0[3]); w.z = cvt_pk_bf16(v1[0], v1[1]); w.w = cvt_pk_bf16(v1[2], v1[3]);
                    *(u32x4*)(Hd + row * 4096 + c) = w;
                }
        }
    }
};
struct EpiY {
    static constexpr bool PERM = false, AFTER_DRAIN = false;
    float* Y; const float* resF; const bf16_t* resB; const float* bias;
    __device__ __forceinline__ void operator()(const f32x4 (&acc)[2][2][4][2], const Unit& u, int wr, int wc, int fr, int fq) const {
        const int row0 = u.pm * BM + wr * 64 + fr, col0 = u.pn * BM + wc * 32 + 4 * fq;
#pragma unroll
        for (int bj = 0; bj < 2; ++bj)
#pragma unroll
            for (int n = 0; n < 2; ++n) {
                const int c = col0 + bj * HALF + n * 16;
                const f32x4 bv = *(const f32x4*)(bias + c);
#pragma unroll
                for (int ai = 0; ai < 2; ++ai)
#pragma unroll
                    for (int m = 0; m < 4; ++m) {
                        const size_t off = (size_t)(row0 + ai * HALF + m * 16) * 1024 + c;
                        f32x4 x;
                        if (resF) x = *(const f32x4*)(resF + off);
                        else { const uint2 xr = *(const uint2*)(resB + off); x[0] = __uint_as_float(xr.x << 16); x[1] = __uint_as_float(xr.x & 0xffff0000u); x[2] = __uint_as_float(xr.y << 16); x[3] = __uint_as_float(xr.y & 0xffff0000u); }
                        *(f32x4*)(Y + off) = x * kAlpha + acc[ai][bj][m][n] + bv;
                    }
            }
    }
};
}
#define PG8_SP2 true
#define PG8_ALIGN true

template <class Epi>
__device__ __forceinline__ void gemm_simple(const bf16_t* __restrict__ A, const bf16_t* __restrict__ Bt, int Mr, int N, int K, const Epi& epi) {
    const int wid = threadIdx.x >> 6, lane = threadIdx.x & 63, wm = wid >> 1, wn = wid & 1;
    const int tilesN = N / 128, ntiles = (Mr / 256) * tilesN;
    for (int t = blockIdx.x; t < ntiles; t += gridDim.x) {
        const int tm = t / tilesN, tn = t % tilesN;
        const int row0 = tm * 256 + wm * 64, col0 = tn * 128 + wn * 64;
        f32x4 acc[4][4];
#pragma unroll
        for (int i = 0; i < 4; ++i)
#pragma unroll
            for (int j = 0; j < 4; ++j) acc[i][j] = (f32x4){0.f, 0.f, 0.f, 0.f};
        const bf16_t* ap = A + (size_t)(row0 + (lane & 15)) * K + 8 * (lane >> 4);
        const bf16_t* bp = Bt + (size_t)(col0 + (lane & 15)) * K + 8 * (lane >> 4);
        for (int k0 = 0; k0 < K; k0 += 32) {
            bf16x8 a[4], b[4];
#pragma unroll
            for (int i = 0; i < 4; ++i) a[i] = *(const bf16x8*)(ap + (size_t)i * 16 * K + k0);
#pragma unroll
            for (int i = 0; i < 4; ++i) b[i] = *(const bf16x8*)(bp + (size_t)i * 16 * K + k0);
#pragma unroll
            for (int i = 0; i < 4; ++i)
#pragma unroll
                for (int j = 0; j < 4; ++j) acc[i][j] = __builtin_amdgcn_mfma_f32_16x16x32_bf16(b[j], a[i], acc[i][j], 0, 0, 0);
        }
#pragma unroll
        for (int i = 0; i < 4; ++i)
#pragma unroll
            for (int j = 0; j < 4; ++j) epi(row0 + i * 16 + (lane & 15), col0 + j * 16 + 4 * (lane >> 4), acc[i][j]);
    }
}

struct EpiIn {
    bf16_t* Z; float* ZS; const float* bias;
    __device__ __forceinline__ void operator()(int r, int c, f32x4 v) const {
        const f32x4 b = *(const f32x4*)(bias + c);
        v += b;
        if (c >= ZC_SM && c < ZC_SM + 32) *(f32x4*)(ZS + (size_t)r * 32 + (c - ZC_SM)) = v;
        const bool qc = (c >= ZC_BQ && c < ZC_BK) || (c >= ZC_CQ && c < ZC_CK) || (c >= ZC_DQ && c < ZC_DKC);
        if (qc) v *= C2;
        uint2 o; o.x = pk2(v[0], v[1]); o.y = pk2(v[2], v[3]);
        *(uint2*)(Z + (size_t)r * NZ + c) = o;
    }
};
struct EpiOut {
    float* Y; const float* res; const float* bias;
    __device__ __forceinline__ void operator()(int r, int c, f32x4 v) const {
        const f32x4 b = *(const f32x4*)(bias + c);
        const f32x4 x = *(const f32x4*)(res + (size_t)r * D + c);
        *(f32x4*)(Y + (size_t)r * D + c) = x * ALPHA + v + b;
    }
};
struct EpiFF1 {
    bf16_t* Hd; const float* bias;
    __device__ __forceinline__ void operator()(int r, int c, f32x4 v) const {
        const f32x4 b = *(const f32x4*)(bias + c);
        v += b;
#pragma unroll
        for (int i = 0; i < 4; ++i) { float t = fmaxf(v[i], 0.f); v[i] = t * t; }
        uint2 o; o.x = pk2(v[0], v[1]); o.y = pk2(v[2], v[3]);
        *(uint2*)(Hd + (size_t)r * DFF + c) = o;
    }
};
struct EpiFF2 {
    float* Y; const bf16_t* X1; const float* bias;
    __device__ __forceinline__ void operator()(int r, int c, f32x4 v) const {
        const f32x4 b = *(const f32x4*)(bias + c);
        const uint2 xr = *(const uint2*)(X1 + (size_t)r * D + c);
        f32x4 x; x[0] = bf2f((bf16_t)(xr.x & 0xffff)); x[1] = bf2f((bf16_t)(xr.x >> 16)); x[2] = bf2f((bf16_t)(xr.y & 0xffff)); x[3] = bf2f((bf16_t)(xr.y >> 16));
        *(f32x4*)(Y + (size_t)r * D + c) = x * ALPHA + v + b;
    }
};

__device__ __forceinline__ void ln_pass(const float* Y, const float* g, const float* b, float* outF, bf16_t* outB) {
    const int lane = threadIdx.x & 63, gw = blockIdx.x * 8 + (threadIdx.x >> 6), NGW = gridDim.x * 8;
    for (int m = gw; m < M; m += NGW) {
        const f32x4* yr = (const f32x4*)(Y + (size_t)m * D) + lane;
        f32x4 v[4]; float s = 0.f;
#pragma unroll
        for (int j = 0; j < 4; ++j) { v[j] = yr[64 * j]; s += (v[j][0] + v[j][1]) + (v[j][2] + v[j][3]); }
        const float mean = wave_sum(s) * (1.f / D); float s2 = 0.f;
#pragma unroll
        for (int j = 0; j < 4; ++j) { v[j] = v[j] - mean; s2 += (v[j][0] * v[j][0] + v[j][1] * v[j][1]) + (v[j][2] * v[j][2] + v[j][3] * v[j][3]); }
        const float rstd = rsqrtf(wave_sum(s2) * (1.f / D) + LN_EPS);
#pragma unroll
        for (int j = 0; j < 4; ++j) {
            const int c = 4 * lane + 256 * j;
            const f32x4 gg = *(const f32x4*)(g + c), bb = *(const f32x4*)(b + c);
            const f32x4 o = v[j] * rstd * gg + bb;
            if (outF) *(f32x4*)(outF + (size_t)m * D + c) = o;
            uint2 w; w.x = pk2(o[0], o[1]); w.y = pk2(o[2], o[3]);
            *(uint2*)(outB + (size_t)m * D + c) = w;
        }
    }
}

template <int NHH>
__device__ __forceinline__ void dot_row(const bf16_t* __restrict__ krow, const float* qs, float (&dot)[NHH]) {
#pragma unroll
    for (int h = 0; h < NHH; ++h) dot[h] = 0.f;
    const uint4* kr = (const uint4*)krow;
#pragma unroll
    for (int c8 = 0; c8 < 8; ++c8) {
        const uint4 kv = kr[c8];
        float kf[8];
        kf[0] = __uint_as_float(kv.x << 16); kf[1] = __uint_as_float(kv.x & 0xffff0000u);
        kf[2] = __uint_as_float(kv.y << 16); kf[3] = __uint_as_float(kv.y & 0xffff0000u);
        kf[4] = __uint_as_float(kv.z << 16); kf[5] = __uint_as_float(kv.z & 0xffff0000u);
        kf[6] = __uint_as_float(kv.w << 16); kf[7] = __uint_as_float(kv.w & 0xffff0000u);
#pragma unroll
        for (int h = 0; h < NHH; ++h)
#pragma unroll
            for (int j = 0; j < 8; ++j) dot[h] += kf[j] * qs[h * 64 + c8 * 8 + j];
    }
}

template <int NHH>
__device__ __forceinline__ void attn_batch(const bf16_t* __restrict__ Kp, const bf16_t* __restrict__ Vp, int pitch, int s, bool valid, int dist, int bh0,
                                           const float* qs, const float* bt, float (&m)[NHH], float (&l)[NHH], float (&acc)[NHH], int lane) {
    unsigned long long vm = __ballot(valid);
    if (vm == 0ull) return;
    float lg[NHH];
#pragma unroll
    for (int h = 0; h < NHH; ++h) lg[h] = -1e30f;
    if (valid) {
        float dot[NHH];
        dot_row<NHH>(Kp + (size_t)s * pitch, qs, dot);
        const int dd = dist > 127 ? 127 : dist;
#pragma unroll
        for (int h = 0; h < NHH; ++h) lg[h] = dot[h] + bt[dd * 12 + bh0 + h];
    }
    float p[NHH];
#pragma unroll
    for (int h = 0; h < NHH; ++h) {
        const float bm = wave_max(lg[h]);
        const float mn = fmaxf(m[h], bm);
        const float sc = exp2f(m[h] - mn);
        p[h] = valid ? exp2f(lg[h] - mn) : 0.f;
        l[h] = l[h] * sc + wave_sum(p[h]);
        acc[h] *= sc; m[h] = mn;
    }
    while (vm) {
        const int kk = __ffsll((long long)vm) - 1; vm &= vm - 1;
        const int sk = __shfl(s, kk);
        const float v = bf2f(Vp[(size_t)sk * pitch + lane]);
#pragma unroll
        for (int h = 0; h < NHH; ++h) acc[h] += __shfl(p[h], kk) * v;
    }
}

__device__ __forceinline__ void mixer_b_naive(const bf16_t* Z, bf16_t* MIX, const float* bt, float* qs_all) {
    const int lane = threadIdx.x & 63, wv = threadIdx.x >> 6, gw = blockIdx.x * 8 + wv, NGW = gridDim.x * 8;
    float* qs = qs_all + wv * 256;
    for (int it = gw; it < M; it += NGW) {
        const int b = it / SEQ, t = it % SEQ;
        const bf16_t* zb = Z + (size_t)b * SEQ * NZ;
        for (int h = 0; h < NH; ++h) {
            qs[lane] = bf2f(zb[(size_t)t * NZ + ZC_BQ + h * 64 + lane]);
            float m[1] = {-1e30f}, l[1] = {0.f}, acc[1] = {0.f};
            const bf16_t* Kp = zb + ZC_BK + h * 64; const bf16_t* Vp = zb + ZC_BV + h * 64;
#pragma unroll
            for (int br = 0; br < 3; ++br) {
                const int dil = br == 0 ? 1 : br == 1 ? 4 : 16;
                const int p = t / dil; const int J = p < 128 ? p : 128;
                for (int jb = 0; jb <= J; jb += 64) {
                    const int j = jb + lane;
                    attn_batch<1>(Kp, Vp, NZ, t - j * dil, j <= J, j * dil, h, qs, bt, m, l, acc, lane);
                }
            }
            MIX[(size_t)it * D + MIX_B + h * 64 + lane] = f2bf(acc[0] / fmaxf(l[0], 1e-30f));
        }
    }
}

__device__ __forceinline__ unsigned mono_key(float f) { unsigned u = __float_as_uint(f); return (u & 0x80000000u) ? ~u : (u | 0x80000000u); }

__device__ __forceinline__ void mixer_c_naive(const bf16_t* Z, const float* ZS, bf16_t* MIX, const float* bt, float* qs_all, unsigned* scl_all) {
    const int lane = threadIdx.x & 63, wv = threadIdx.x >> 6, gw = blockIdx.x * 8 + wv, NGW = gridDim.x * 8;
    float* qs = qs_all + wv * 256; unsigned* scl = scl_all + wv * 2048;
    for (int it0 = gw; it0 < M; it0 += NGW) {
        const int b = it0 / SEQ; int t = it0 % SEQ; t = (t & 1) ? (SEQ - 1 - (t >> 1)) : (t >> 1);
        const int it = b * SEQ + t;
        const bf16_t* zb = Z + (size_t)b * SEQ * NZ;
#pragma unroll
        for (int h = 0; h < 4; ++h) qs[h * 64 + lane] = bf2f(zb[(size_t)t * NZ + ZC_CIQ + h * 64 + lane]);
        float iw[4];
#pragma unroll
        for (int h = 0; h < 4; ++h) iw[h] = ZS[(size_t)it * 32 + 8 + h] * 0.0625f;
        const int ni = t / 64 + 1;
        for (int i = 0; i < ni; ++i) {
            const int s = lane + 64 * i;
            unsigned key = 0u;
            if (s <= t) {
                float dot[4];
                dot_row<4>(zb + (size_t)s * NZ + ZC_CIK, qs, dot);
                float sc = 0.f;
#pragma unroll
                for (int h = 0; h < 4; ++h) sc += fmaxf(dot[h], 0.f) * iw[h];
                if (sc == 0.f) sc = 0.f;
                key = mono_key(sc);
            }
            scl[i * 64 + lane] = key;
        }
        unsigned kreg[32];
#pragma unroll
        for (int i = 0; i < 32; ++i) kreg[i] = (i < ni) ? scl[i * 64 + lane] : 0u;
        unsigned selbits = 0u;
        if (t + 1 <= 256) {
#pragma unroll
            for (int i = 0; i < 32; ++i) if (i < ni && lane + 64 * i <= t) selbits |= 1u << i;
        } else {
            unsigned T = 0u;
            for (int bit = 31; bit >= 0; --bit) {
                const unsigned cand = T | (1u << bit);
                int cnt = 0;
#pragma unroll
                for (int i = 0; i < 32; ++i) if (i < ni) cnt += __popcll(__ballot(kreg[i] >= cand));
                if (cnt >= 256) T = cand;
            }
            int ngt = 0;
#pragma unroll
            for (int i = 0; i < 32; ++i) if (i < ni) ngt += __popcll(__ballot(kreg[i] > T));
            const int r = 256 - ngt; int run = 0;
            const unsigned long long lower = (1ull << lane) - 1ull;
#pragma unroll
            for (int i = 0; i < 32; ++i) if (i < ni) {
                const bool eq = kreg[i] == T;
                const unsigned long long em = __ballot(eq);
                const int pre = run + __popcll(em & lower);
                if (kreg[i] > T || (eq && pre < r)) selbits |= 1u << i;
                run += __popcll(em);
            }
        }
#pragma unroll
        for (int h = 0; h < 4; ++h) qs[h * 64 + lane] = bf2f(zb[(size_t)t * NZ + ZC_CQ + h * 64 + lane]);
        float m[4], l[4], acc[4];
#pragma unroll
        for (int h = 0; h < 4; ++h) { m[h] = -1e30f; l[h] = 0.f; acc[h] = 0.f; }
        for (int i = 0; i < ni; ++i) {
            const int s = lane + 64 * i;
            attn_batch<4>(zb + ZC_CK, zb + ZC_CV, NZ, s, ((selbits >> i) & 1u) != 0u && s <= t, t - s, 4, qs, bt, m, l, acc, lane);
        }
#pragma unroll
        for (int h = 0; h < 4; ++h) MIX[(size_t)it * D + MIX_C + h * 64 + lane] = f2bf(acc[h] / fmaxf(l[h], 1e-30f));
    }
}

__device__ __forceinline__ void nsa_compress_naive(const bf16_t* Z, const float* pos, const float* w1, const float* w2, bf16_t* KV, float* lds) {
    float* in = lds; float* hid = lds + 8 * 2048;
    const int tid = threadIdx.x;
    const int ngroups = (BATCH * NCMP) / 8;
    for (int item = blockIdx.x; item < 2 * ngroups; item += gridDim.x) {
        const int which = item / ngroups, g = item % ngroups;
        const int zc = which == 0 ? ZC_DKC : ZC_DVC;
        __syncthreads();
        for (int e = tid; e < 8 * 2048; e += 512) {
            const int rr = e >> 11, k = e & 2047, r = g * 8 + rr, b = r / NCMP, c = r % NCMP, p = k >> 6, d = k & 63;
            in[e] = bf2f(Z[((size_t)b * SEQ + 16 * c + p) * NZ + zc + d]) + pos[which * 2048 + k];
        }
        __syncthreads();
        {
            const int j = tid & 255, rh = tid >> 8;
            const float* w = w1 + (size_t)which * 2048 * 256 + j;
            float a0 = 0.f, a1 = 0.f, a2 = 0.f, a3 = 0.f;
            const float* i0 = in + (rh * 4) * 2048;
            for (int k = 0; k < 2048; ++k) {
                const float ww = w[(size_t)k * 256];
                a0 += i0[k] * ww; a1 += i0[2048 + k] * ww; a2 += i0[4096 + k] * ww; a3 += i0[6144 + k] * ww;
            }
            hid[(rh * 4 + 0) * 256 + j] = siluf_(a0); hid[(rh * 4 + 1) * 256 + j] = siluf_(a1);
            hid[(rh * 4 + 2) * 256 + j] = siluf_(a2); hid[(rh * 4 + 3) * 256 + j] = siluf_(a3);
        }
        __syncthreads();
        {
            const int rr = tid >> 6, d = tid & 63, r = g * 8 + rr, b = r / NCMP, c = r % NCMP;
            const float* w = w2 + (size_t)which * 256 * 64 + d;
            float a = 0.f;
            for (int j = 0; j < 256; ++j) a += hid[rr * 256 + j] * w[j * 64];
            KV[(size_t)which * BATCH * 128 * 64 + ((size_t)b * 128 + c) * 64 + d] = f2bf(a);
        }
    }
}

__device__ __forceinline__ void mixer_d_naive(const bf16_t* Z, const float* ZS, const bf16_t* KV, bf16_t* MIX, const float* bt, float* qs_all, float* ps_all) {
    const int lane = threadIdx.x & 63, wv = threadIdx.x >> 6, gw = blockIdx.x * 8 + wv, NGW = gridDim.x * 8;
    float* qs = qs_all + wv * 256; float* ps = ps_all + wv * 136 + 4;
    for (int it0 = gw; it0 < M; it0 += NGW) {
        const int b = it0 / SEQ; int t = it0 % SEQ; t = (t & 1) ? (SEQ - 1 - (t >> 1)) : (t >> 1);
        const int it = b * SEQ + t;
        const bf16_t* zb = Z + (size_t)b * SEQ * NZ;
#pragma unroll
        for (int h = 0; h < 4; ++h) qs[h * 64 + lane] = bf2f(zb[(size_t)t * NZ + ZC_DQ + h * 64 + lane]);
        const bf16_t* kc = KV + (size_t)b * 128 * 64; const bf16_t* vc = KV + (size_t)BATCH * 128 * 64 + (size_t)b * 128 * 64;
        const int nc = t >= 31 ? (t - 31) / 16 + 1 : 0;
        float lg[2][4]; float oc[4];
#pragma unroll
        for (int h = 0; h < 4; ++h) oc[h] = 0.f;
        float psum[2] = {0.f, 0.f};
        if (nc > 0) {
#pragma unroll
            for (int i = 0; i < 2; ++i) {
                const int c = lane + 64 * i;
#pragma unroll
                for (int h = 0; h < 4; ++h) lg[i][h] = -1e30f;
                if (c < nc) {
                    float dot[4]; dot_row<4>(kc + (size_t)c * 64, qs, dot);
                    int dd = t - (16 * c + 31); dd = dd > 127 ? 127 : dd;
#pragma unroll
                    for (int h = 0; h < 4; ++h) lg[i][h] = dot[h] + bt[dd * 12 + 8 + h];
                }
            }
            float pn[2][4];
#pragma unroll
            for (int h = 0; h < 4; ++h) {
                const float mx = wave_max(fmaxf(lg[0][h], lg[1][h]));
                const float p0 = (lane < nc) ? exp2f(lg[0][h] - mx) : 0.f, p1 = (lane + 64 < nc) ? exp2f(lg[1][h] - mx) : 0.f;
                const float den = fmaxf(wave_sum(p0 + p1), 1e-30f);
                pn[0][h] = p0 / den; pn[1][h] = p1 / den;
                psum[0] += pn[0][h]; psum[1] += pn[1][h];
            }
            for (int c = 0; c < nc; ++c) {
                const float v = bf2f(vc[(size_t)c * 64 + lane]);
#pragma unroll
                for (int h = 0; h < 4; ++h) oc[h] += __shfl(c < 64 ? pn[0][h] : pn[1][h], c & 63) * v;
            }
        }
        ps[lane] = psum[0]; ps[64 + lane] = (lane + 64 < NCMP) ? psum[1] : 0.f; if (lane == 0) { ps[-1] = 0.f; ps[128] = 0.f; }
        __builtin_amdgcn_s_waitcnt(0); __builtin_amdgcn_wave_barrier();
        const int cur = t >> 6;
        float imp = -1e30f; bool adm = false;
        if (lane < 32) {
            const int j = lane;
            imp = 0.5f * ps[4 * j - 1] + ps[4 * j] + ps[4 * j + 1] + ps[4 * j + 2] + 0.5f * ps[4 * j + 3];
            if (j == 0 || j == cur || j == cur - 1) imp = 1e9f;
            adm = (64 * j <= t);
            if (!adm) imp = -1e30f;
        }
        int rank = 0;
#pragma unroll
        for (int jj = 0; jj < 32; ++jj) { const float o = __shfl(imp, jj); rank += (o > imp || (o == imp && jj < lane)) ? 1 : 0; }
        const unsigned selmask = (unsigned)__ballot(lane < 32 && adm && rank < 16);
        __builtin_amdgcn_wave_barrier();
        float m[4], l[4], acc[4];
#pragma unroll
        for (int h = 0; h < 4; ++h) { m[h] = -1e30f; l[h] = 0.f; acc[h] = 0.f; }
        for (int j = 0; j <= cur; ++j) {
            if (!((selmask >> j) & 1u)) continue;
            const int s = 64 * j + lane;
            attn_batch<4>(zb + ZC_DKS, zb + ZC_DVS, NZ, s, s <= t, t - s, 8, qs, bt, m, l, acc, lane);
        }
        float os[4];
#pragma unroll
        for (int h = 0; h < 4; ++h) { os[h] = acc[h] / fmaxf(l[h], 1e-30f); m[h] = -1e30f; l[h] = 0.f; acc[h] = 0.f; }
        for (int i = 0; i < 8; ++i) {
            const int dist = i * 64 + lane, s = t - dist;
            attn_batch<4>(zb + ZC_DKW, zb + ZC_DVW, NZ, s, s >= 0, dist, 8, qs, bt, m, l, acc, lane);
        }
#pragma unroll
        for (int h = 0; h < 4; ++h) {
            const float ow = acc[h] / fmaxf(l[h], 1e-30f);
            const float g0 = sigmoidf_(ZS[(size_t)it * 32 + 12 + 3 * h + 0]), g1 = sigmoidf_(ZS[(size_t)it * 32 + 12 + 3 * h + 1]), g2 = sigmoidf_(ZS[(size_t)it * 32 + 12 + 3 * h + 2]);
            MIX[(size_t)it * D + MIX_D + h * 64 + lane] = f2bf(g0 * oc[h] + g1 * os[h] + g2 * ow);
        }
    }
}

__device__ __forceinline__ float conv_silu(const bf16_t* zb, const float* cw, int t, int ch) {
    float a = 0.f;
#pragma unroll
    for (int j = 0; j < 4; ++j) { const int tt = t - 3 + j; if (tt >= 0) a += cw[j * 256 + ch] * bf2f(zb[(size_t)tt * NZ + ch]); }
    return siluf_(a);
}
__device__ __forceinline__ void mlstm_local(const bf16_t* Z, const float* ZS, const float* cw, float* U, float* usm, float* lds) {
    float* wk = lds;
    float* vv = lds + 2048;
    float* sm = lds + 2048 + 4096;
    const int tid = threadIdx.x, lane = tid & 63;
    for (int item = blockIdx.x; item < BATCH * NH * 32; item += gridDim.x) {
        const int b = item / 128, h = (item / 32) % 4, c = item % 32;
        const bf16_t* zb = Z + (size_t)b * SEQ * NZ;
        __syncthreads();
        if (tid < 64) {
            const int t = 64 * c + lane; const size_t row = (size_t)b * SEQ + t;
            const float f = ZS[row * 32 + 4 + h], ig = ZS[row * 32 + h];
            const float lf = fminf(f, 0.f) - log1pf(__expf(-fabsf(f)));
            float bb = lf;
#pragma unroll
            for (int o = 1; o < 64; o <<= 1) { const float n = __shfl_up(bb, o); if (lane >= o) bb += n; }
            const float bL = __shfl(bb, 63);
            const float g = bL - bb + ig;
            const float G = wave_max(g);
            sm[lane] = __expf(g - G);
            if (lane == 0) { usm[2048 * 32 + item] = G; usm[2048 * 32 + 2048 + item] = bL; }
        }
        __syncthreads();
        for (int e = tid; e < 64 * 32; e += 512) { const int s = e >> 5, d = e & 31; wk[e] = sm[s] * conv_silu(zb, cw, 64 * c + s, 128 + h * 32 + d) * 0.17677669529663687f; }
        for (int e = tid; e < 64 * 64; e += 512) { const int s = e >> 6, d = e & 63; vv[e] = bf2f(zb[(size_t)(64 * c + s) * NZ + ZC_AV + h * 64 + d]); }
        __syncthreads();
        {
            const int d = tid >> 4, e0 = (tid & 15) * 4;
            float a0 = 0.f, a1 = 0.f, a2 = 0.f, a3 = 0.f;
            for (int s = 0; s < 64; ++s) { const float k = wk[s * 32 + d]; a0 += k * vv[s * 64 + e0]; a1 += k * vv[s * 64 + e0 + 1]; a2 += k * vv[s * 64 + e0 + 2]; a3 += k * vv[s * 64 + e0 + 3]; }
            *(f32x4*)(U + (size_t)item * 2048 + d * 64 + e0) = (f32x4){a0, a1, a2, a3};
        }
        if (tid < 32) { float a = 0.f; for (int s = 0; s < 64; ++s) a += wk[s * 32 + tid]; usm[item * 32 + tid] = a; }
    }
}
__device__ __forceinline__ void mlstm_out(const bf16_t* Z, const float* ZS, const float* cw, const float* U, const float* usm, const float* norm_g, bf16_t* MIX, float* lds) {
    float* qv = lds;
    float* kv = qv + 2048;
    float* vv = kv + 2048;
    float* Cs = vv + 4096;
    float* sc = Cs + 2048;
    float* hb = sc + 4096;
    float* nv = hb + 4096;
    float* bb_s = nv + 32;
    float* ii_s = bb_s + 64;
    float* mt_s = ii_s + 64;
    float* wi_s = mt_s + 64;
    float* den_s = wi_s + 64;
    float* coef = den_s + 64;
    float* misc = coef + 32;
    const int tid = threadIdx.x, lane = tid & 63, wv = tid >> 6;
    for (int item = blockIdx.x; item < BATCH * NH * 32; item += gridDim.x) {
        const int b = item / 128, h = (item / 32) % 4, c = item % 32;
        const bf16_t* zb = Z + (size_t)b * SEQ * NZ;
        const int item0 = item - c;
        __syncthreads();
        if (tid < 64) {
            const int t = 64 * c + lane; const size_t row = (size_t)b * SEQ + t;
            const float f = ZS[row * 32 + 4 + h], ig = ZS[row * 32 + h];
            const float lf = fminf(f, 0.f) - log1pf(__expf(-fabsf(f)));
            float bb = lf;
#pragma unroll
            for (int o = 1; o < 64; o <<= 1) { const float n = __shfl_up(bb, o); if (lane >= o) bb += n; }
            bb_s[lane] = bb; ii_s[lane] = ig;
            float mc = 0.f;
            for (int j = 0; j < c; ++j) { const float G = usm[2048 * 32 + item0 + j], bL = usm[2048 * 32 + 2048 + item0 + j]; mc = fmaxf(bL + mc, G); }
            if (lane < 32) {
                float cf = 0.f;
                if (lane < c) { float sfx = 0.f; for (int q = lane + 1; q < c; ++q) sfx += usm[2048 * 32 + 2048 + item0 + q]; cf = __expf(usm[2048 * 32 + item0 + lane] + sfx - mc); }
                coef[lane] = cf;
            }
            if (lane == 0) misc[0] = mc;
        }
        for (int e = tid; e < 64 * 32; e += 512) { const int s = e >> 5, d = e & 31; qv[e] = conv_silu(zb, cw, 64 * c + s, h * 32 + d); kv[e] = conv_silu(zb, cw, 64 * c + s, 128 + h * 32 + d) * 0.17677669529663687f; }
        for (int e = tid; e < 64 * 64; e += 512) { const int s = e >> 6, d = e & 63; vv[e] = bf2f(zb[(size_t)(64 * c + s) * NZ + ZC_AV + h * 64 + d]); }
        __syncthreads();
        {
            f32x4 a = (f32x4){0.f, 0.f, 0.f, 0.f};
            for (int j = 0; j < c; ++j) a += coef[j] * *(const f32x4*)(U + (size_t)(item0 + j) * 2048 + tid * 4);
            *(f32x4*)(Cs + tid * 4) = a;
            if (tid < 32) { float n = 0.f; for (int j = 0; j < c; ++j) n += coef[j] * usm[(item0 + j) * 32 + tid]; nv[tid] = n; }
        }
        if (tid < 64) {
            const float mc = misc[0]; const float bt_ = bb_s[lane];
            float mx = -1e30f;
            for (int s = 0; s <= lane; ++s) mx = fmaxf(mx, bt_ - bb_s[s] + ii_s[s]);
            const float mt = fmaxf(bt_ + mc, mx);
            mt_s[lane] = mt; wi_s[lane] = __expf(bt_ + mc - mt);
        }
        __syncthreads();
        for (int e = tid; e < 4096; e += 512) {
            const int t = e >> 6, s = e & 63; float v = 0.f;
            if (s <= t) { float dt = 0.f; for (int d = 0; d < 32; ++d) dt += qv[t * 32 + d] * kv[s * 32 + d]; v = dt * __expf(bb_s[t] - bb_s[s] + ii_s[s] - mt_s[t]); }
            sc[e] = v;
        }
        __syncthreads();
        if (tid < 64) {
            float dn = 0.f; for (int s = 0; s < 64; ++s) dn += sc[tid * 64 + s];
            float qn = 0.f; for (int d = 0; d < 32; ++d) qn += qv[tid * 32 + d] * nv[d];
            dn += wi_s[tid] * qn;
            den_s[tid] = fmaxf(fabsf(dn), __expf(-mt_s[tid]));
        }
        __syncthreads();
        for (int e = tid; e < 4096; e += 512) {
            const int t = e >> 6, d = e & 63; float a = 0.f, qc = 0.f;
            for (int s = 0; s < 64; ++s) a += sc[t * 64 + s] * vv[s * 64 + d];
            for (int k = 0; k < 32; ++k) qc += qv[t * 32 + k] * Cs[k * 64 + d];
            const float hh = (a + wi_s[t] * qc) / den_s[t];
            const float og = bf2f(zb[(size_t)(64 * c + t) * NZ + ZC_AO + h * 64 + d]);
            hb[e] = sigmoidf_(og) * hh;
        }
        __syncthreads();
        for (int tt = wv; tt < 64; tt += 8) {
            const float v = hb[tt * 64 + lane];
            const float mu = wave_sum(v) * (1.f / 64.f); const float dv = v - mu;
            const float var = wave_sum(dv * dv) * (1.f / 64.f);
            MIX[((size_t)b * SEQ + 64 * c + tt) * D + MIX_A + h * 64 + lane] = f2bf(dv * rsqrtf(var + LN_EPS) * norm_g[h * 64 + lane]);
        }
    }
}

typedef float f32x16 __attribute__((ext_vector_type(16)));
typedef short s16x4 __attribute__((ext_vector_type(4)));
#define LAS3 __attribute__((address_space(3)))
constexpr int KT_STRIDE = 144;
constexpr int KT_BYTES = 64 * KT_STRIDE, VT_BYTES = 64 * 128, STG_BYTES = KT_BYTES + VT_BYTES;
constexpr int FA_BT = 0, FA_FSC = 6144, FA_STG = 8192;
constexpr float FA_MINIT = -1.0e4f, FA_MASKED = -1.0e30f;

typedef float f32x2_t __attribute__((ext_vector_type(2))); typedef __bf16 bf16x2_t __attribute__((ext_vector_type(2)));
__device__ __forceinline__ unsigned cvtpk(float lo, float hi) { f32x2_t v = {lo, hi}; bf16x2_t b = __builtin_convertvector(v, bf16x2_t); return __builtin_bit_cast(unsigned, b); }
__device__ __forceinline__ bf16x8 pack8(const f32x16& x, int s8) {
    typedef unsigned u32x4_ __attribute__((ext_vector_type(4)));
    u32x4_ p; p[0] = cvtpk(x[s8], x[s8 + 1]); p[1] = cvtpk(x[s8 + 2], x[s8 + 3]); p[2] = cvtpk(x[s8 + 4], x[s8 + 5]); p[3] = cvtpk(x[s8 + 6], x[s8 + 7]);
    return __builtin_bit_cast(bf16x8, p);
}
__device__ __forceinline__ s16x4 tr_read16(const LAS3 unsigned char* p) {
    typedef short v4i16_t __attribute__((ext_vector_type(4)));
    return __builtin_bit_cast(s16x4, __builtin_amdgcn_ds_read_tr16_b64_v4i16((LAS3 v4i16_t*)p));
}
struct FAState { f32x16 o0, o1; float m, l; };
__device__ __forceinline__ void fa_init(FAState& st) {
#pragma unroll
    for (int r = 0; r < 16; ++r) { st.o0[r] = 0.f; st.o1[r] = 0.f; }
    st.m = FA_MINIT; st.l = 0.f;
}
typedef unsigned u32x4v __attribute__((ext_vector_type(4)));
template <int CPT> struct TileRegs { u32x4v k[CPT], v[CPT]; };
template <int CPT, class RowFn>
__device__ __forceinline__ void tile_load(TileRegs<CPT>& tr, const bf16_t* __restrict__ kbase, const bf16_t* __restrict__ vbase, int pitch, RowFn rowfn, int lt) {
#pragma unroll
    for (int c = 0; c < CPT; ++c) {
        const int idx = c * (512 / CPT) + lt, row = idx >> 3, ch = idx & 7;
        const long g = rowfn(row);
        if (g >= 0) { tr.k[c] = *(const u32x4v*)(kbase + g * pitch + ch * 8); tr.v[c] = *(const u32x4v*)(vbase + g * pitch + ch * 8); }
        else { tr.k[c] = (u32x4v){0u, 0u, 0u, 0u}; tr.v[c] = (u32x4v){0u, 0u, 0u, 0u}; }
    }
}
template <int CPT>
__device__ __forceinline__ void tile_store(const TileRegs<CPT>& tr, LAS3 unsigned char* stg, int lt) {
#pragma unroll
    for (int c = 0; c < CPT; ++c) {
        const int idx = c * (512 / CPT) + lt, row = idx >> 3, ch = idx & 7;
        *(LAS3 u32x4v*)(stg + row * KT_STRIDE + ch * 16) = tr.k[c];
        *(LAS3 u32x4v*)(stg + KT_BYTES + row * 128 + ((ch * 16) ^ (((row >> 1) & 1) << 6))) = tr.v[c];
    }
}
__device__ __forceinline__ void fa_scores(f32x16& p0, f32x16& p1, const bf16x8 (&qf)[4], const LAS3 unsigned char* stg, float cinit, int lane) {
    const int r32 = lane & 31, hi = lane >> 5;
#pragma unroll
    for (int r = 0; r < 16; ++r) { p0[r] = cinit; p1[r] = cinit; }
    const LAS3 unsigned char* kp = stg + r32 * KT_STRIDE + hi * 16;
#pragma unroll
    for (int ks = 0; ks < 4; ++ks) {
        const bf16x8 a0 = *(const LAS3 bf16x8*)(kp + ks * 32);
        const bf16x8 a1 = *(const LAS3 bf16x8*)(kp + 32 * KT_STRIDE + ks * 32);
        p0 = __builtin_amdgcn_mfma_f32_32x32x16_bf16(a0, qf[ks], p0, 0, 0, 0);
        p1 = __builtin_amdgcn_mfma_f32_32x32x16_bf16(a1, qf[ks], p1, 0, 0, 0);
    }
}
__device__ __forceinline__ void fa_pv(f32x16& o0, f32x16& o1, const f32x16& p0, const f32x16& p1, const LAS3 unsigned char* stg, int lane) {
    const int hi = lane >> 5;
    bf16x8 pa[4];
    pa[0] = pack8(p0, 0); pa[1] = pack8(p0, 8); pa[2] = pack8(p1, 0); pa[3] = pack8(p1, 8);
    const int i16 = lane & 15, dh = (lane >> 4) & 1;
    const LAS3 unsigned char* vb = stg + KT_BYTES + (4 * hi + (i16 >> 2)) * 128;
    const int colb = 32 * dh + 8 * (i16 & 3), sw = ((lane >> 3) & 1) << 6;
#pragma unroll
    for (int kk = 0; kk < 4; ++kk) {
        const LAS3 unsigned char* vk = vb + (16 * kk) * 128;
#pragma unroll
        for (int d0 = 0; d0 < 2; ++d0) {
            const int off = (64 * d0 + colb) ^ sw;
            const s16x4 lo = tr_read16(vk + off), hh = tr_read16(vk + 8 * 128 + off);
            const bf16x8 vf = __builtin_shufflevector(lo, hh, 0, 1, 2, 3, 4, 5, 6, 7);
            if (d0 == 0) o0 = __builtin_amdgcn_mfma_f32_32x32x16_bf16(pa[kk], vf, o0, 0, 0, 0);
            else o1 = __builtin_amdgcn_mfma_f32_32x32x16_bf16(pa[kk], vf, o1, 0, 0, 0);
        }
    }
}
template <class Fix>
__device__ __forceinline__ void fa_tile(FAState& st, const bf16x8 (&qf)[4], const LAS3 unsigned char* stg, float cinit, const Fix& fix, LAS3 float* fsc, int lane) {
    const int r32 = lane & 31, hi = lane >> 5;
    f32x16 p0, p1;
    fa_scores(p0, p1, qf, stg, cinit, lane);
    fix(p0, p1);
    float mx = fmaxf(p0[0], p1[0]);
#pragma unroll
    for (int r = 1; r < 16; ++r) mx = fmaxf(mx, fmaxf(p0[r], p1[r]));
    mx = fmaxf(mx, __shfl_xor(mx, 32));
    if (__any(mx > st.m)) {
        const float mn = fmaxf(st.m, mx), f = __builtin_amdgcn_exp2f(st.m - mn);
        st.l *= f; st.m = mn;
        fsc[r32] = f;
        __builtin_amdgcn_s_waitcnt(0xc07f);
        __builtin_amdgcn_wave_barrier();
#pragma unroll
        for (int r = 0; r < 16; ++r) { const float fr = fsc[(r & 3) + 8 * (r >> 2) + 4 * hi]; st.o0[r] *= fr; st.o1[r] *= fr; }
        __builtin_amdgcn_wave_barrier();
    }
    float ls = 0.f;
#pragma unroll
    for (int r = 0; r < 16; ++r) { p0[r] = __builtin_amdgcn_exp2f(p0[r] - st.m); p1[r] = __builtin_amdgcn_exp2f(p1[r] - st.m); ls += p0[r] + p1[r]; }
    st.l += ls;
    fa_pv(st.o0, st.o1, p0, p1, stg, lane);
}
__device__ __forceinline__ void fa_finish(FAState& st, LAS3 float* fsc, int lane) {
    const int r32 = lane & 31, hi = lane >> 5;
    const float lt = st.l + __shfl_xor(st.l, 32);
    fsc[r32] = 1.f / fmaxf(lt, 1e-30f);
    __builtin_amdgcn_s_waitcnt(0xc07f);
    __builtin_amdgcn_wave_barrier();
#pragma unroll
    for (int r = 0; r < 16; ++r) { const float fr = fsc[(r & 3) + 8 * (r >> 2) + 4 * hi]; st.o0[r] *= fr; st.o1[r] *= fr; }
    __builtin_amdgcn_wave_barrier();
}
__device__ __forceinline__ void fa_store_bf16(const f32x16& o0, const f32x16& o1, bf16_t* dst, int pitch, int lane) {
    const int r32 = lane & 31, hi = lane >> 5;
#pragma unroll
    for (int r = 0; r < 16; ++r) {
        const int q = (r & 3) + 8 * (r >> 2) + 4 * hi;
        dst[(size_t)q * pitch + r32] = f2bf(o0[r]); dst[(size_t)q * pitch + 32 + r32] = f2bf(o1[r]);
    }
}

constexpr int C_MASK = FA_STG;
constexpr int C_SCL = C_MASK + 64 * 32 * 8;
constexpr int C_STG = C_SCL;
constexpr int C_END = C_SCL + 16 * 2048 * 4;
template <int NI>
__device__ __forceinline__ int count_ge(const unsigned (&k)[32], unsigned cand) {
    int c = 0;
#pragma unroll
    for (int i = 0; i < NI; ++i) c += __popcll(__ballot(k[i] >= cand));
    return c;
}
template <int NI>
__device__ __forceinline__ unsigned long long select256(const unsigned (&kreg)[32], int lane) {
    unsigned T = 0u;
    for (int bit = 31; bit >= 0; --bit) {
        const unsigned cand = T | (1u << bit);
        const int cnt = count_ge<NI>(kreg, cand);
        if (cnt >= 256) { T = cand; if (cnt == 256) break; }
    }
    int ngt = 0;
#pragma unroll
    for (int i = 0; i < NI; ++i) ngt += __popcll(__ballot(kreg[i] > T));
    const int rr = 256 - ngt; int run = 0;
    const unsigned long long lower = (1ull << lane) - 1ull;
    unsigned long long myword = 0ull;
#pragma unroll
    for (int i = 0; i < NI; ++i) {
        const bool eq = kreg[i] == T;
        const unsigned long long em = __ballot(eq);
        const int pre = run + __popcll(em & lower);
        const unsigned long long m64 = __ballot(kreg[i] > T || (eq && pre < rr));
        if (lane == i) myword = m64;
        run += __popcll(em);
    }
    return myword;
}
__device__ __forceinline__ void mixer_c_fast(const bf16_t* Z, const float* ZS, bf16_t* MIX, unsigned char* lds_gen) {
    LAS3 unsigned char* lds = (LAS3 unsigned char*)lds_gen;
    const LAS3 float* bt = (const LAS3 float*)(lds + FA_BT);
    for (int item = blockIdx.x; item < BATCH * 32; item += gridDim.x) {
        int tid = threadIdx.x; asm volatile("" : "+v"(tid));
        const int lane = tid & 63, w = __builtin_amdgcn_readfirstlane(tid >> 6), r32 = lane & 31, hi = lane >> 5;
        LAS3 float* fsc = (LAS3 float*)(lds + FA_FSC) + w * 32;
        LAS3 unsigned* scl = (LAS3 unsigned*)(lds + C_SCL);
        LAS3 unsigned long long* maskL = (LAS3 unsigned long long*)(lds + C_MASK);
        const int b = item & 15, qt = item < 256 ? 31 - (item >> 4) : (item - 256) >> 4;
        const bf16_t* zb = Z + (size_t)b * SEQ * NZ;
        __syncthreads();
        for (int rd = 0; rd < 4; ++rd) {
            const int tq0 = 64 * qt + 16 * rd, nk32 = (tq0 + 15) / 32 + 1;
            bf16x8 af[2][4];
            f32x4 iwv[2][4];
#pragma unroll
            for (int rb = 0; rb < 2; ++rb) {
#pragma unroll
                for (int ks = 0; ks < 4; ++ks) af[rb][ks] = *(const bf16x8*)(zb + (size_t)(tq0 + 8 * rb + (r32 >> 2)) * NZ + ZC_CIQ + (r32 & 3) * 64 + 16 * ks + 8 * hi);
#pragma unroll
                for (int i = 0; i < 4; ++i) iwv[rb][i] = *(const f32x4*)(ZS + ((size_t)b * SEQ + tq0 + 8 * rb + 2 * i + hi) * 32 + 8) * 0.0625f;
            }
            for (int tile = w; tile < nk32; tile += 16) {
                const bool two = tile + 8 < nk32;
                const bf16_t* kr0 = zb + (size_t)(32 * tile + r32) * NZ + ZC_CIK + 8 * hi;
                const bf16_t* kr1 = kr0 + (size_t)(32 * 8) * NZ;
                bf16x8 bf0[4], bf1[4];
#pragma unroll
                for (int ks = 0; ks < 4; ++ks) bf0[ks] = *(const bf16x8*)(kr0 + 16 * ks);
                if (two) {
#pragma unroll
                    for (int ks = 0; ks < 4; ++ks) bf1[ks] = *(const bf16x8*)(kr1 + 16 * ks);
                }
#pragma unroll
                for (int u = 0; u < 2; ++u) {
                    if (u == 1 && !two) break;
                    const int key = 32 * (tile + 8 * u) + r32;
#pragma unroll
                    for (int rb = 0; rb < 2; ++rb) {
                        f32x16 acc;
#pragma unroll
                        for (int r = 0; r < 16; ++r) acc[r] = 0.f;
#pragma unroll
                        for (int ks = 0; ks < 4; ++ks) acc = __builtin_amdgcn_mfma_f32_32x32x16_bf16(af[rb][ks], u == 0 ? bf0[ks] : bf1[ks], acc, 0, 0, 0);
#pragma unroll
                        for (int i = 0; i < 4; ++i) {
                            float sc = 0.f;
#pragma unroll
                            for (int j = 0; j < 4; ++j) sc += fmaxf(acc[4 * i + j], 0.f) * iwv[rb][i][j];
                            if (sc == 0.f) sc = 0.f;
                            const int tq = tq0 + 8 * rb + 2 * i + hi;
                            scl[(8 * rb + 2 * i + hi) * 2048 + key] = key <= tq ? mono_key(sc) : 0u;
                        }
                    }
                }
            }
            __syncthreads();
#pragma unroll 1
            for (int qq = 0; qq < 2; ++qq) {
                const int ql = 2 * w + qq, tq = tq0 + ql, ni = tq / 64 + 1;
                unsigned kreg[32];
#pragma unroll
                for (int i = 0; i < 32; ++i) kreg[i] = (i < ni && lane + 64 * i <= tq) ? scl[ql * 2048 + 64 * i + lane] : 0u;
                unsigned long long myword = 0ull;
                if (tq + 1 <= 256) {
#pragma unroll
                    for (int i = 0; i < 4; ++i) { const unsigned long long m64 = __ballot(lane + 64 * i <= tq); if (lane == i) myword = m64; }
                } else if (ni <= 8) myword = select256<8>(kreg, lane);
                else if (ni <= 16) myword = select256<16>(kreg, lane);
                else if (ni <= 24) myword = select256<24>(kreg, lane);
                else myword = select256<32>(kreg, lane);
                if (lane < 32) maskL[(16 * rd + ql) * 32 + lane] = myword;
            }
            __syncthreads();
        }
        {
            const int h = w & 3, sub = w >> 2, t0 = 64 * qt + 32 * sub, tq = t0 + r32;
            bf16x8 qf[4];
#pragma unroll
            for (int ks = 0; ks < 4; ++ks) qf[ks] = *(const bf16x8*)(zb + (size_t)tq * NZ + ZC_CQ + h * 64 + 16 * ks + 8 * hi);
            FAState st; fa_init(st);
            TileRegs<1> tr;
            const bf16_t* kb = zb + ZC_CK; const bf16_t* vb = zb + ZC_CV;
            tile_load<1>(tr, kb, vb, NZ, [&](int row) { return (long)row; }, tid);
            tile_store<1>(tr, lds + C_STG, tid);
            __syncthreads();
            for (int kt = 0; kt <= qt; ++kt) {
                const int s0 = 64 * kt;
                if (kt < qt) tile_load<1>(tr, kb, vb, NZ, [&](int row) { return (long)(s0 + 64 + row); }, tid);
                const unsigned long long w64 = maskL[(32 * sub + r32) * 32 + kt];
                if (__any(w64 != 0ull)) {
                    const bool near = (t0 - (s0 + 63)) < 113;
                    const float cinit = near ? 0.f : bt[127 * 12 + 4 + h];
                    const unsigned wl = (unsigned)w64 >> (4 * hi), wh = (unsigned)(w64 >> 32) >> (4 * hi);
                    auto fix = [&](f32x16& p0, f32x16& p1) {
#pragma unroll
                        for (int r = 0; r < 16; ++r) {
                            const int cp = (r & 3) + 8 * (r >> 2);
                            if (near) {
                                int d0_ = tq - (s0 + cp + 4 * hi); int d1_ = d0_ - 32;
                                d0_ = d0_ < 0 ? 0 : (d0_ > 127 ? 127 : d0_); d1_ = d1_ < 0 ? 0 : (d1_ > 127 ? 127 : d1_);
                                p0[r] += bt[d0_ * 12 + 4 + h]; p1[r] += bt[d1_ * 12 + 4 + h];
                            }
                            p0[r] = ((wl >> cp) & 1u) ? p0[r] : FA_MASKED; p1[r] = ((wh >> cp) & 1u) ? p1[r] : FA_MASKED;
                        }
                    };
                    fa_tile(st, qf, lds + C_STG + (kt & 1) * STG_BYTES, cinit, fix, fsc, lane);
                }
                if (kt < qt) tile_store<1>(tr, lds + C_STG + ((kt + 1) & 1) * STG_BYTES, tid);
                __syncthreads();
            }
            fa_finish(st, fsc, lane);
            fa_store_bf16(st.o0, st.o1, MIX + ((size_t)b * SEQ + t0) * D + MIX_C + h * 64, D, lane);
        }
    }
}

constexpr int D_SELM = 7168;
constexpr int D_GATE = FA_STG + 2 * STG_BYTES;
constexpr int D_IMPL = D_GATE + 64 * 12 * 4;
constexpr int D_IMPS = D_IMPL + 4 * 64 * 32 * 4;
constexpr int D_RES = D_IMPS + 64 * 32 * 4;
constexpr int D_END = D_RES + 8 * 32 * 64 * 4;
template <bool FIRST>
__device__ __forceinline__ void acc_gated(LAS3 float* resL, const f32x16& o0, const f32x16& o1, const LAS3 float* gate, int hi, int lane) {
#pragma unroll
    for (int r = 0; r < 16; ++r) {
        const float g = gate[((r & 3) + 8 * (r >> 2) + 4 * hi) * 12];
        if (FIRST) { resL[(2 * r) * 64 + lane] = g * o0[r]; resL[(2 * r + 1) * 64 + lane] = g * o1[r]; }
        else { resL[(2 * r) * 64 + lane] += g * o0[r]; resL[(2 * r + 1) * 64 + lane] += g * o1[r]; }
    }
}
__device__ __forceinline__ void mixer_d_fast(const bf16_t* Z, const float* ZS, const bf16_t* KV, bf16_t* MIX, unsigned char* lds_gen) {
    LAS3 unsigned char* lds = (LAS3 unsigned char*)lds_gen;
    const LAS3 float* bt = (const LAS3 float*)(lds + FA_BT);
    for (int item = blockIdx.x; item < BATCH * 32; item += gridDim.x) {
        int tid = threadIdx.x; asm volatile("" : "+v"(tid));
        const int lane = tid & 63, w = __builtin_amdgcn_readfirstlane(tid >> 6), r32 = lane & 31, hi = lane >> 5;
        LAS3 float* fsc = (LAS3 float*)(lds + FA_FSC) + w * 32;
        LAS3 unsigned* selm = (LAS3 unsigned*)(lds + D_SELM);
        LAS3 float* gate = (LAS3 float*)(lds + D_GATE);
        LAS3 float* impl = (LAS3 float*)(lds + D_IMPL);
        LAS3 float* imps = (LAS3 float*)(lds + D_IMPS);
        const int h = w & 3, sub = w >> 2;
        const int b = item & 15, qt = item < 256 ? 31 - (item >> 4) : (item - 256) >> 4;
        const bf16_t* zb = Z + (size_t)b * SEQ * NZ;
        const int t0 = 64 * qt + 32 * sub, tq = t0 + r32;
        __syncthreads();
        for (int e = tid; e < 64 * 12; e += 512) gate[e] = sigmoidf_(ZS[((size_t)b * SEQ + 64 * qt + e / 12) * 32 + 12 + e % 12]);
        bf16x8 qf[4];
#pragma unroll
        for (int ks = 0; ks < 4; ++ks) qf[ks] = *(const bf16x8*)(zb + (size_t)tq * NZ + ZC_DQ + h * 64 + 16 * ks + 8 * hi);
        LAS3 float* resL = (LAS3 float*)(lds + D_RES) + w * 2048;
        const LAS3 float* gbase = gate + (32 * sub) * 12 + 3 * h;
        TileRegs<1> tr;
        {
            const bf16_t* kc = KV + (size_t)b * 128 * 64; const bf16_t* vc = KV + (size_t)BATCH * 128 * 64 + (size_t)b * 128 * 64;
            const bool two = qt >= 16;
            tile_load<1>(tr, kc, vc, 64, [&](int row) { return (long)row; }, tid);
            tile_store<1>(tr, lds + FA_STG, tid);
            if (two) {
                tile_load<1>(tr, kc, vc, 64, [&](int row) { return row < 63 ? (long)(64 + row) : -1L; }, tid);
                tile_store<1>(tr, lds + FA_STG + STG_BYTES, tid);
            }
            __syncthreads();
            f32x16 p0, p1, p2, p3;
            fa_scores(p0, p1, qf, lds + FA_STG, 0.f, lane);
            if (two) fa_scores(p2, p3, qf, lds + FA_STG + STG_BYTES, 0.f, lane);
            float mx = FA_MASKED;
            auto fixc = [&](float v, int c) -> float {
                int dist = tq - (16 * c + 31);
                const bool valid = dist >= 0;
                dist = dist < 0 ? 0 : (dist > 127 ? 127 : dist);
                return valid ? v + bt[dist * 12 + 8 + h] : FA_MASKED;
            };
#pragma unroll
            for (int r = 0; r < 16; ++r) {
                const int c0 = (r & 3) + 8 * (r >> 2) + 4 * hi;
                p0[r] = fixc(p0[r], c0); p1[r] = fixc(p1[r], c0 + 32);
                if (two) { p2[r] = fixc(p2[r], c0 + 64); p3[r] = fixc(p3[r], c0 + 96); } else { p2[r] = FA_MASKED; p3[r] = FA_MASKED; }
                mx = fmaxf(fmaxf(mx, fmaxf(p0[r], p1[r])), fmaxf(p2[r], p3[r]));
            }
            mx = fmaxf(mx, __shfl_xor(mx, 32));
            if (mx < -1.0e29f) mx = 0.f;
            float ls = 0.f;
#pragma unroll
            for (int r = 0; r < 16; ++r) {
                p0[r] = __builtin_amdgcn_exp2f(p0[r] - mx); p1[r] = __builtin_amdgcn_exp2f(p1[r] - mx);
                p2[r] = __builtin_amdgcn_exp2f(p2[r] - mx); p3[r] = __builtin_amdgcn_exp2f(p3[r] - mx);
                ls += (p0[r] + p1[r]) + (p2[r] + p3[r]);
            }
            const float inv = 1.f / fmaxf(ls + __shfl_xor(ls, 32), 1e-30f);
            float bprev = 0.f;
#pragma unroll
            for (int gi = 0; gi < 16; ++gi) {
                const int rr = gi & 3, sel = gi >> 2;
                const f32x16& P = sel == 0 ? p0 : sel == 1 ? p1 : sel == 2 ? p2 : p3;
                const float Bc = 0.5f * P[4 * rr + 3] * inv;
                const float Ac = (P[4 * rr] + P[4 * rr + 1] + P[4 * rr + 2]) * inv + Bc;
                const float bp = __shfl_xor(Bc, 32);
                impl[(h * 64 + 32 * sub + r32) * 32 + 2 * gi + hi] = Ac + (hi ? bp : bprev);
                bprev = bp;
            }
            FAState sc; fa_init(sc); sc.l = ls;
            fa_pv(sc.o0, sc.o1, p0, p1, lds + FA_STG, lane);
            if (two) fa_pv(sc.o0, sc.o1, p2, p3, lds + FA_STG + STG_BYTES, lane);
            fa_finish(sc, fsc, lane);
            acc_gated<true>(resL, sc.o0, sc.o1, gbase + 0, hi, lane);
        }
        __syncthreads();
#pragma unroll
        for (int k = 0; k < 4; ++k) {
            const int pi = tid + 512 * k, q = pi >> 5, jj = pi & 31;
            float v = ((impl[(0 * 64 + q) * 32 + jj] + impl[(1 * 64 + q) * 32 + jj]) + impl[(2 * 64 + q) * 32 + jj]) + impl[(3 * 64 + q) * 32 + jj];
            if (jj == 0 || jj == qt || jj == qt - 1) v = 1e9f;
            if (jj > qt) v = -1e30f;
            imps[pi] = v;
        }
        __syncthreads();
#pragma unroll
        for (int k = 0; k < 4; ++k) {
            const int pi = tid + 512 * k, q = pi >> 5, jj = pi & 31;
            const float my = imps[pi]; int rank = 0;
#pragma unroll
            for (int j2 = 0; j2 < 32; ++j2) { const float o = imps[q * 32 + j2]; rank += (o > my || (o == my && j2 < jj)) ? 1 : 0; }
            const unsigned long long m64 = __ballot(jj <= qt && rank < 16);
            if (lane == 0) { selm[2 * w + 16 * k] = (unsigned)m64; selm[2 * w + 16 * k + 1] = (unsigned)(m64 >> 32); }
        }
        __syncthreads();
        {
            unsigned bm = selm[lane];
#pragma unroll
            for (int o = 32; o; o >>= 1) bm |= __shfl_xor(bm, o);
            bm = __builtin_amdgcn_readfirstlane(bm);
            const unsigned mysel = selm[32 * sub + r32];
            const bf16_t* kb = zb + ZC_DKS; const bf16_t* vb = zb + ZC_DVS;
            FAState st; fa_init(st);
            int j = __ffs(bm) - 1, idx = 0;
            tile_load<1>(tr, kb, vb, NZ, [&](int row) { return (long)(64 * j + row); }, tid);
            tile_store<1>(tr, lds + FA_STG, tid);
            __syncthreads();
            for (;;) {
                bm &= bm - 1;
                const int jn = bm ? __ffs(bm) - 1 : -1;
                if (jn >= 0) tile_load<1>(tr, kb, vb, NZ, [&](int row) { return (long)(64 * jn + row); }, tid);
                const bool on = (mysel >> j) & 1u;
                if (__any(on)) {
                    const int s0 = 64 * j;
                    const bool near = (t0 - (s0 + 63)) < 113;
                    const float cinit = near ? 0.f : bt[127 * 12 + 8 + h];
                    auto fix = [&](f32x16& p0, f32x16& p1) {
#pragma unroll
                        for (int r = 0; r < 16; ++r) {
                            const int cp = (r & 3) + 8 * (r >> 2) + 4 * hi;
                            const int d0_ = tq - (s0 + cp), d1_ = d0_ - 32;
                            if (near) {
                                const int e0 = d0_ < 0 ? 0 : (d0_ > 127 ? 127 : d0_), e1 = d1_ < 0 ? 0 : (d1_ > 127 ? 127 : d1_);
                                p0[r] += bt[e0 * 12 + 8 + h]; p1[r] += bt[e1 * 12 + 8 + h];
                            }
                            p0[r] = (on && d0_ >= 0) ? p0[r] : FA_MASKED; p1[r] = (on && d1_ >= 0) ? p1[r] : FA_MASKED;
                        }
                    };
                    fa_tile(st, qf, lds + FA_STG + (idx & 1) * STG_BYTES, cinit, fix, fsc, lane);
                }
                if (jn >= 0) tile_store<1>(tr, lds + FA_STG + ((idx + 1) & 1) * STG_BYTES, tid);
                __syncthreads();
                if (jn < 0) break;
                j = jn; ++idx;
            }
            fa_finish(st, fsc, lane);
            acc_gated<false>(resL, st.o0, st.o1, gbase + 1, hi, lane);
        }
        {
            const bf16_t* kb = zb + ZC_DKW; const bf16_t* vb = zb + ZC_DVW;
            FAState st; fa_init(st);
            const int k0 = qt > 8 ? qt - 8 : 0;
            tile_load<1>(tr, kb, vb, NZ, [&](int row) { return (long)(64 * k0 + row); }, tid);
            tile_store<1>(tr, lds + FA_STG, tid);
            __syncthreads();
            for (int kt = k0; kt <= qt; ++kt) {
                const int s0 = 64 * kt, idx = kt - k0;
                if (kt < qt) tile_load<1>(tr, kb, vb, NZ, [&](int row) { return (long)(s0 + 64 + row); }, tid);
                if (t0 - s0 < 512 + 63) {
                    const bool near = (t0 - (s0 + 63)) < 113;
                    const float cinit = near ? 0.f : bt[127 * 12 + 8 + h];
                    auto fix = [&](f32x16& p0, f32x16& p1) {
#pragma unroll
                        for (int r = 0; r < 16; ++r) {
                            const int cp = (r & 3) + 8 * (r >> 2) + 4 * hi;
                            const int d0_ = tq - (s0 + cp), d1_ = d0_ - 32;
                            if (near) {
                                const int e0 = d0_ < 0 ? 0 : (d0_ > 127 ? 127 : d0_), e1 = d1_ < 0 ? 0 : (d1_ > 127 ? 127 : d1_);
                                p0[r] += bt[e0 * 12 + 8 + h]; p1[r] += bt[e1 * 12 + 8 + h];
                            }
                            p0[r] = (d0_ >= 0 && d0_ < 512) ? p0[r] : FA_MASKED; p1[r] = (d1_ >= 0 && d1_ < 512) ? p1[r] : FA_MASKED;
                        }
                    };
                    fa_tile(st, qf, lds + FA_STG + (idx & 1) * STG_BYTES, cinit, fix, fsc, lane);
                }
                if (kt < qt) tile_store<1>(tr, lds + FA_STG + ((idx + 1) & 1) * STG_BYTES, tid);
                __syncthreads();
            }
            fa_finish(st, fsc, lane);
            const LAS3 float* g2 = gbase + 2;
#pragma unroll
            for (int r = 0; r < 16; ++r) {
                const float g = g2[((r & 3) + 8 * (r >> 2) + 4 * hi) * 12];
                st.o0[r] = resL[(2 * r) * 64 + lane] + g * st.o0[r]; st.o1[r] = resL[(2 * r + 1) * 64 + lane] + g * st.o1[r];
            }
            fa_store_bf16(st.o0, st.o1, MIX + ((size_t)b * SEQ + t0) * D + MIX_D + h * 64, D, lane);
        }
    }
}

__device__ __forceinline__ void mixer_b_fast(const bf16_t* Z, float* PBO, float* PBL, unsigned char* lds_gen) {
    LAS3 unsigned char* lds = (LAS3 unsigned char*)lds_gen;
    const LAS3 float* bt = (const LAS3 float*)(lds + FA_BT);
    for (int item = blockIdx.x; item < 1536; item += gridDim.x) {
        int tid = threadIdx.x; asm volatile("" : "+v"(tid));
        const int lane = tid & 63, w = __builtin_amdgcn_readfirstlane(tid >> 6), r32 = lane & 31, hi = lane >> 5;
        LAS3 float* fsc = (LAS3 float*)(lds + FA_FSC) + w * 32;
        const int strm = w >> 2, wv = w & 3, lt = tid & 255;
        const int bh = item & 63, lp = item >> 6, br = lp >> 3, k = 2 * (lp & 7) + strm;
        const int b = bh >> 2, h = bh & 3;
        const int dil = br == 0 ? 1 : br == 1 ? 4 : 16;
        const int res = br == 0 ? 0 : br == 1 ? (k >> 2) : k;
        const int n = br == 0 ? k : br == 1 ? (k & 3) : 0;
        const bf16_t* zb = Z + (size_t)b * SEQ * NZ;
        const bf16_t* kb = zb + ZC_BK + h * 64; const bf16_t* vb = zb + ZC_BV + h * 64;
        const int relq = 128 + 32 * wv + r32;
        const int tok = res + dil * (128 * n + 32 * wv + r32);
        bf16x8 qf[4];
#pragma unroll
        for (int ks = 0; ks < 4; ++ks) qf[ks] = *(const bf16x8*)(zb + (size_t)tok * NZ + ZC_BQ + h * 64 + 16 * ks + 8 * hi);
        FAState st; fa_init(st);
        LAS3 unsigned char* sbase = lds + FA_STG + strm * 2 * STG_BYTES;
        const int kt0 = n > 0 ? 0 : 2;
        TileRegs<2> tr;
        __syncthreads();
        tile_load<2>(tr, kb, vb, NZ, [&](int row) { return (long)(res + dil * (128 * (n - 1) + 64 * kt0 + row)); }, lt);
        tile_store<2>(tr, sbase + (kt0 & 1) * STG_BYTES, lt);
        __syncthreads();
        for (int kt = 0; kt < 4; ++kt) {
            const bool have = kt >= kt0, havenext = kt + 1 < 4 && kt + 1 > kt0;
            if (havenext) tile_load<2>(tr, kb, vb, NZ, [&](int row) { return (long)(res + dil * (128 * (n - 1) + 64 * (kt + 1) + row)); }, lt);
            if (have && kt >= (wv >> 1) && kt <= (wv >> 1) + 2) {
                const int relk0 = 64 * kt;
                const bool near = (128 + 32 * wv - (relk0 + 63)) * dil < 113;
                const float cinit = near ? 0.f : bt[127 * 12 + h];
                auto fix = [&](f32x16& p0, f32x16& p1) {
#pragma unroll
                    for (int r = 0; r < 16; ++r) {
                        const int cp = (r & 3) + 8 * (r >> 2) + 4 * hi;
                        const int j0 = relq - (relk0 + cp), j1 = j0 - 32;
                        if (near) {
                            int e0 = j0 * dil, e1 = j1 * dil;
                            e0 = e0 < 0 ? 0 : (e0 > 127 ? 127 : e0); e1 = e1 < 0 ? 0 : (e1 > 127 ? 127 : e1);
                            p0[r] += bt[e0 * 12 + h]; p1[r] += bt[e1 * 12 + h];
                        }
                        p0[r] = (j0 >= 0 && j0 <= 128) ? p0[r] : FA_MASKED; p1[r] = (j1 >= 0 && j1 <= 128) ? p1[r] : FA_MASKED;
                    }
                };
                fa_tile(st, qf, sbase + (kt & 1) * STG_BYTES, cinit, fix, fsc, lane);
            }
            if (havenext) tile_store<2>(tr, sbase + ((kt + 1) & 1) * STG_BYTES, lt);
            __syncthreads();
        }
        const float ltot = st.l + __shfl_xor(st.l, 32);
        if (hi == 0) PBL[((size_t)br * M + (size_t)b * SEQ + tok) * 4 + h] = st.m + log2f(fmaxf(ltot, 1e-30f));
        fa_finish(st, fsc, lane);
#pragma unroll
        for (int r = 0; r < 16; ++r) {
            const int q = (r & 3) + 8 * (r >> 2) + 4 * hi;
            const int tk = res + dil * (128 * n + 32 * wv + q);
            float* dst = PBO + (((size_t)br * M + (size_t)b * SEQ + tk) * 4 + h) * 64;
            dst[r32] = st.o0[r]; dst[32 + r32] = st.o1[r];
        }
    }
}
__device__ __forceinline__ void mixer_b_combine(const float* PBO, const float* PBL, bf16_t* MIX) {
    const int lane = threadIdx.x & 63, gw = blockIdx.x * 8 + (threadIdx.x >> 6), NGW = gridDim.x * 8;
    for (int it = gw; it < M * 4; it += NGW) {
        const float l0 = PBL[it], l1 = PBL[(size_t)M * 4 + it], l2 = PBL[(size_t)2 * M * 4 + it];
        const float mx = fmaxf(l0, fmaxf(l1, l2));
        const float w0 = exp2f(l0 - mx), w1 = exp2f(l1 - mx), w2 = exp2f(l2 - mx), inv = 1.f / (w0 + w1 + w2);
        const float o = w0 * PBO[(size_t)it * 64 + lane] + w1 * PBO[((size_t)M * 4 + it) * 64 + lane] + w2 * PBO[((size_t)2 * M * 4 + it) * 64 + lane];
        MIX[(size_t)(it >> 2) * D + MIX_B + (it & 3) * 64 + lane] = f2bf(o * inv);
    }
}

constexpr int A_WAVE = 10240;
constexpr int A_VEC = 8192;
__device__ __forceinline__ void pv32(f32x16& o0, f32x16& o1, const f32x16& p, const LAS3 unsigned char* vt, int kb0, int lane) {
    const int hi = lane >> 5, i16 = lane & 15, dh = (lane >> 4) & 1;
    const bf16x8 pa0 = pack8(p, 0), pa1 = pack8(p, 8);
    const LAS3 unsigned char* vb = vt + (kb0 + 4 * hi + (i16 >> 2)) * 128;
    const int colb = 32 * dh + 8 * (i16 & 3), sw = ((lane >> 3) & 1) << 6;
#pragma unroll
    for (int kk = 0; kk < 2; ++kk)
#pragma unroll
        for (int d0 = 0; d0 < 2; ++d0) {
            const int off = (64 * d0 + colb) ^ sw;
            const s16x4 lo = tr_read16(vb + (16 * kk) * 128 + off), hh = tr_read16(vb + (16 * kk + 8) * 128 + off);
            const bf16x8 vf = __builtin_shufflevector(lo, hh, 0, 1, 2, 3, 4, 5, 6, 7);
            if (d0 == 0) o0 = __builtin_amdgcn_mfma_f32_32x32x16_bf16(kk == 0 ? pa0 : pa1, vf, o0, 0, 0, 0);
            else o1 = __builtin_amdgcn_mfma_f32_32x32x16_bf16(kk == 0 ? pa0 : pa1, vf, o1, 0, 0, 0);
        }
}
__device__ __forceinline__ void a_load_v(LAS3 unsigned char* wl, const bf16_t* vsrc  , int lane) {
    u32x4v t[8];
#pragma unroll
    for (int j = 0; j < 8; ++j) { const int idx = j * 64 + lane, row = idx >> 3, ch = idx & 7; t[j] = *(const u32x4v*)(vsrc + (size_t)row * NZ + ch * 8); }
#pragma unroll
    for (int j = 0; j < 8; ++j) { const int idx = j * 64 + lane, row = idx >> 3, ch = idx & 7; *(LAS3 u32x4v*)(wl + row * 128 + ((ch * 16) ^ (((row >> 1) & 1) << 6))) = t[j]; }
}
__device__ __forceinline__ float wave_scan_add(float v, int lane) {
#pragma unroll
    for (int o = 1; o < 64; o <<= 1) { const float n = __shfl_up(v, o); if (lane >= o) v += n; }
    return v;
}
__device__ __forceinline__ float wave_scan_max(float v, int lane) {
#pragma unroll
    for (int o = 1; o < 64; o <<= 1) { const float n = __shfl_up(v, o); if (lane >= o) v = fmaxf(v, n); }
    return v;
}
__device__ __forceinline__ bf16x8 pack8f(const float (&v)[8], float s) {
    typedef unsigned u32x4_ __attribute__((ext_vector_type(4)));
    u32x4_ pk; pk[0] = cvtpk(v[0] * s, v[1] * s); pk[1] = cvtpk(v[2] * s, v[3] * s); pk[2] = cvtpk(v[4] * s, v[5] * s); pk[3] = cvtpk(v[6] * s, v[7] * s);
    return __builtin_bit_cast(bf16x8, pk);
}
__device__ __forceinline__ float bf_round(float x) { return bf2f(f2bf(x)); }
__device__ __forceinline__ void pack8f_split(const float (&v)[8], float s, bf16x8& hi, bf16x8& lo) {
    float a[8], b[8];
#pragma unroll
    for (int j = 0; j < 8; ++j) { a[j] = v[j] * s; b[j] = a[j] - bf_round(a[j]); }
    hi = pack8f(a, 1.f); lo = pack8f(b, 1.f);
}
__device__ __forceinline__ void lo_part(const f32x16& x, f32x16& lo) {
#pragma unroll
    for (int r = 0; r < 16; ++r) lo[r] = x[r] - bf_round(x[r]);
}
__device__ __forceinline__ void mlstm_local_fast(const bf16_t* Z, const float* ZS, const float* cw, float* UF, float* usm, unsigned char* lds_gen) {
    LAS3 unsigned char* lds = (LAS3 unsigned char*)lds_gen;
    for (int it0 = blockIdx.x * 8; it0 < BATCH * NH * 32; it0 += gridDim.x * 8) {
        int tid = threadIdx.x; asm volatile("" : "+v"(tid));
        const int lane = tid & 63, w = __builtin_amdgcn_readfirstlane(tid >> 6), r32 = lane & 31, hi = lane >> 5;
        const int item = it0 + w, b = item >> 7, h = (item >> 5) & 3, c = item & 31;
        LAS3 unsigned char* wl = lds + FA_STG + w * A_WAVE;
        LAS3 float* vec = (LAS3 float*)(wl + A_VEC);
        const bf16_t* zb = Z + (size_t)b * SEQ * NZ;
        {
            const size_t row = (size_t)b * SEQ + 64 * c + lane;
            const float f = ZS[row * 32 + 4 + h], ig = ZS[row * 32 + h];
            const float lf = fminf(f, 0.f) - log1pf(__expf(-fabsf(f)));
            const float bb = wave_scan_add(lf, lane);
            const float bL = __shfl(bb, 63);
            const float g = bL - bb + ig;
            const float G = wave_max(g);
            vec[lane] = __expf(g - G);
            if (lane == 0) { usm[2048 * 32 + item] = G; usm[2048 * 32 + 2048 + item] = bL; }
        }
        a_load_v(wl, zb + (size_t)(64 * c) * NZ + ZC_AV + h * 64, lane);
        bf16x8 af[4], al[4]; float usum = 0.f;
        {
            const int ch = 128 + h * 32 + r32;
            const float c0 = cw[ch], c1 = cw[256 + ch], c2 = cw[512 + ch], c3 = cw[768 + ch];
#pragma unroll
            for (int ks = 0; ks < 4; ++ks) {
                const int s0 = 16 * ks + 8 * hi, t0 = 64 * c + s0 - 3;
                float x[11];
#pragma unroll
                for (int j = 0; j < 11; ++j) x[j] = (t0 + j >= 0) ? bf2f(zb[(size_t)(t0 + j) * NZ + ch]) : 0.f;
                float kv[8];
#pragma unroll
                for (int j = 0; j < 8; ++j) {
                    const float cv = c0 * x[j] + c1 * x[j + 1] + c2 * x[j + 2] + c3 * x[j + 3];
                    kv[j] = siluf_(cv) * 0.17677669529663687f * vec[s0 + j];
                    usum += kv[j];
                }
                pack8f_split(kv, 1.f, af[ks], al[ks]);
            }
        }
        usum += __shfl_xor(usum, 32);
        if (hi == 0) usm[item * 32 + r32] = usum;
        f32x16 U0, U1;
#pragma unroll
        for (int r = 0; r < 16; ++r) { U0[r] = 0.f; U1[r] = 0.f; }
        {
            const int i16 = lane & 15, dh = (lane >> 4) & 1;
            const LAS3 unsigned char* vb = wl + (8 * hi + (i16 >> 2)) * 128;
            const int colb = 32 * dh + 8 * (i16 & 3), sw = ((lane >> 3) & 1) << 6;
#pragma unroll
            for (int ks = 0; ks < 4; ++ks)
#pragma unroll
                for (int eb = 0; eb < 2; ++eb) {
                    const int off = (64 * eb + colb) ^ sw;
                    const s16x4 lo = tr_read16(vb + (16 * ks) * 128 + off), hh = tr_read16(vb + (16 * ks + 4) * 128 + off);
                    const bf16x8 vf = __builtin_shufflevector(lo, hh, 0, 1, 2, 3, 4, 5, 6, 7);
                    if (eb == 0) { U0 = __builtin_amdgcn_mfma_f32_32x32x16_bf16(af[ks], vf, U0, 0, 0, 0); U0 = __builtin_amdgcn_mfma_f32_32x32x16_bf16(al[ks], vf, U0, 0, 0, 0); }
                    else { U1 = __builtin_amdgcn_mfma_f32_32x32x16_bf16(af[ks], vf, U1, 0, 0, 0); U1 = __builtin_amdgcn_mfma_f32_32x32x16_bf16(al[ks], vf, U1, 0, 0, 0); }
                }
        }
        float* ud = UF + (size_t)item * 2048 + lane;
#pragma unroll
        for (int r = 0; r < 16; ++r) { ud[r * 64] = U0[r]; ud[(16 + r) * 64] = U1[r]; }
    }
}
__device__ __forceinline__ void conv_frags(float (&o)[2][8], const bf16_t* zb, const float* cw, int t, int chbase, int hi) {
#pragma unroll
    for (int cg = 0; cg < 2; ++cg) {
        const int ch0 = chbase + 16 * cg + 8 * hi;
        float a[8];
#pragma unroll
        for (int j = 0; j < 8; ++j) a[j] = 0.f;
#pragma unroll
        for (int jj = 0; jj < 4; ++jj) {
            const int tt = t - 3 + jj;
            if (tt >= 0) {
                const u32x4v zv = *(const u32x4v*)(zb + (size_t)tt * NZ + ch0);
                const f32x4 c0 = *(const f32x4*)(cw + jj * 256 + ch0), c1 = *(const f32x4*)(cw + jj * 256 + ch0 + 4);
                a[0] += c0[0] * __uint_as_float(zv[0] << 16); a[1] += c0[1] * __uint_as_float(zv[0] & 0xffff0000u);
                a[2] += c0[2] * __uint_as_float(zv[1] << 16); a[3] += c0[3] * __uint_as_float(zv[1] & 0xffff0000u);
                a[4] += c1[0] * __uint_as_float(zv[2] << 16); a[5] += c1[1] * __uint_as_float(zv[2] & 0xffff0000u);
                a[6] += c1[2] * __uint_as_float(zv[3] << 16); a[7] += c1[3] * __uint_as_float(zv[3] & 0xffff0000u);
            }
        }
#pragma unroll
        for (int j = 0; j < 8; ++j) o[cg][j] = siluf_(a[j]);
    }
}
__device__ __forceinline__ bf16x8 to_krow(bf16x8 f, int hi) {
    typedef unsigned u32x4_ __attribute__((ext_vector_type(4)));
    const u32x4_ v = __builtin_bit_cast(u32x4_, f);
    const unsigned s0 = hi ? v[0] : v[2], s1 = hi ? v[1] : v[3];
    const unsigned y0 = __shfl_xor(s0, 32), y1 = __shfl_xor(s1, 32);
    u32x4_ n; n[0] = hi ? y0 : v[0]; n[1] = hi ? y1 : v[1]; n[2] = hi ? v[2] : y0; n[3] = hi ? v[3] : y1;
    return __builtin_bit_cast(bf16x8, n);
}
__device__ __forceinline__ void mlstm_out_fast(const bf16_t* Z, const float* ZS, const float* cw, const float* UF, const float* usm, const float* norm_g, bf16_t* MIX, unsigned char* lds_gen) {
    LAS3 unsigned char* lds = (LAS3 unsigned char*)lds_gen;
    for (int it0 = blockIdx.x * 8; it0 < BATCH * NH * 32; it0 += gridDim.x * 8) {
        int tid = threadIdx.x; asm volatile("" : "+v"(tid));
        const int lane = tid & 63, w = __builtin_amdgcn_readfirstlane(tid >> 6), r32 = lane & 31, hi = lane >> 5;
        const int item = it0 + w, b = item >> 7, h = (item >> 5) & 3, c = item & 31, item0 = item - c;
        LAS3 unsigned char* wl = lds + FA_STG + w * A_WAVE;
        LAS3 float* vec = (LAS3 float*)(wl + A_VEC);
        const bf16_t* zb = Z + (size_t)b * SEQ * NZ;
        a_load_v(wl, zb + (size_t)(64 * c) * NZ + ZC_AV + h * 64, lane);
        float mc = 0.f, coefv = 0.f;
        {
            const size_t row = (size_t)b * SEQ + 64 * c + lane;
            const float f = ZS[row * 32 + 4 + h], ig = ZS[row * 32 + h];
            const float lf = fminf(f, 0.f) - log1pf(__expf(-fabsf(f)));
            const float bb = wave_scan_add(lf, lane);
            const float a = ig - bb;
            const float pm = wave_scan_max(a, lane);
            const float Gv = lane < c ? usm[2048 * 32 + item0 + lane] : -1e30f, bLv = lane < c ? usm[2048 * 32 + 2048 + item0 + lane] : 0.f;
            for (int j = 0; j < c; ++j) mc = fmaxf(__shfl(bLv, j) + mc, __shfl(Gv, j));
            const float incl = wave_scan_add(bLv, lane);
            const float tot = __shfl(incl, 63);
            coefv = lane < c ? __expf(Gv + (tot - incl) - mc) : 0.f;
            const float mx = fmaxf(mc, pm);
            vec[lane] = a; vec[64 + lane] = -mx; vec[128 + lane] = __expf(mc - mx); vec[192 + lane] = __expf(-(bb + mx));
        }
        f32x16 C0, C1; float nacc = 0.f;
#pragma unroll
        for (int r = 0; r < 16; ++r) { C0[r] = 0.f; C1[r] = 0.f; }
        for (int j = 0; j < c; ++j) {
            const float cf = __shfl(coefv, j);
            const float* us = UF + (size_t)(item0 + j) * 2048 + lane;
#pragma unroll
            for (int r = 0; r < 16; ++r) { C0[r] += cf * us[r * 64]; C1[r] += cf * us[(16 + r) * 64]; }
            nacc += cf * usm[(item0 + j) * 32 + r32];
        }
        vec[256 + r32] = nacc;
        bf16x8 cbh[2][2], cbl[2][2];
        {
            f32x16 L0, L1; lo_part(C0, L0); lo_part(C1, L1);
            cbh[0][0] = pack8(C0, 0); cbh[0][1] = pack8(C0, 8); cbh[1][0] = pack8(C1, 0); cbh[1][1] = pack8(C1, 8);
            cbl[0][0] = pack8(L0, 0); cbl[0][1] = pack8(L0, 8); cbl[1][0] = pack8(L1, 0); cbl[1][1] = pack8(L1, 8);
        }
        bf16x8 kh[2][2], kl[2][2];
        {
            float o[2][8];
            conv_frags(o, zb, cw, 64 * c + r32, 128 + h * 32, hi);
            pack8f_split(o[0], 0.17677669529663687f, kh[0][0], kl[0][0]); pack8f_split(o[1], 0.17677669529663687f, kh[0][1], kl[0][1]);
        }
#pragma unroll
        for (int tb = 0; tb < 2; ++tb) {
            const int tl = r32 + 32 * tb;
            const float rt = vec[64 + tl];
            if (tb == 1) {
                float o[2][8];
                conv_frags(o, zb, cw, 64 * c + r32 + 32, 128 + h * 32, hi);
                pack8f_split(o[0], 0.17677669529663687f, kh[1][0], kl[1][0]); pack8f_split(o[1], 0.17677669529663687f, kh[1][1], kl[1][1]);
            }
            bf16x8 qh[2], ql[2], qsh[2];
            float qnv;
            {
                float o[2][8];
                conv_frags(o, zb, cw, 64 * c + tl, h * 32, hi);
                pack8f_split(o[0], 1.f, qh[0], ql[0]); pack8f_split(o[1], 1.f, qh[1], ql[1]);
                const float wi = vec[128 + tl];
                bf16x8 th, tlw;
                pack8f_split(o[0], wi, th, tlw); qsh[0] = to_krow(th, hi);
                pack8f_split(o[1], wi, th, tlw); qsh[1] = to_krow(th, hi);
                float d = 0.f;
#pragma unroll
                for (int cg = 0; cg < 2; ++cg)
#pragma unroll
                    for (int j = 0; j < 8; ++j) d += o[cg][j] * vec[256 + 16 * cg + 8 * hi + j];
                qnv = d + __shfl_xor(d, 32);
            }
            f32x16 H0, H1;
#pragma unroll
            for (int r = 0; r < 16; ++r) { H0[r] = 0.f; H1[r] = 0.f; }
#pragma unroll
            for (int s = 0; s < 2; ++s) {
                H0 = __builtin_amdgcn_mfma_f32_32x32x16_bf16(qsh[s], cbh[0][s], H0, 0, 0, 0);
                H0 = __builtin_amdgcn_mfma_f32_32x32x16_bf16(qsh[s], cbl[0][s], H0, 0, 0, 0);
                H1 = __builtin_amdgcn_mfma_f32_32x32x16_bf16(qsh[s], cbh[1][s], H1, 0, 0, 0);
                H1 = __builtin_amdgcn_mfma_f32_32x32x16_bf16(qsh[s], cbl[1][s], H1, 0, 0, 0);
            }
            float dsum = 0.f;
#pragma unroll
            for (int sb = 0; sb <= tb; ++sb) {
                f32x16 S;
#pragma unroll
                for (int r = 0; r < 16; ++r) S[r] = 0.f;
#pragma unroll
                for (int ks = 0; ks < 2; ++ks) {
                    S = __builtin_amdgcn_mfma_f32_32x32x16_bf16(kh[sb][ks], qh[ks], S, 0, 0, 0);
                    S = __builtin_amdgcn_mfma_f32_32x32x16_bf16(kh[sb][ks], ql[ks], S, 0, 0, 0);
                    S = __builtin_amdgcn_mfma_f32_32x32x16_bf16(kl[sb][ks], qh[ks], S, 0, 0, 0);
                }
#pragma unroll
                for (int r = 0; r < 16; ++r) {
                    const int sl = (r & 3) + 8 * (r >> 2) + 4 * hi + 32 * sb;
                    const float dec = __expf(rt + vec[sl]);
                    S[r] = (sl <= tl) ? S[r] * dec : 0.f;
                    dsum += S[r];
                }
                f32x16 SL; lo_part(S, SL);
                pv32(H0, H1, S, wl, 32 * sb, lane);
                pv32(H0, H1, SL, wl, 32 * sb, lane);
            }
            dsum += __shfl_xor(dsum, 32);
            const float den = dsum + vec[128 + tl] * qnv;
            const float dmax = fmaxf(fabsf(den), vec[192 + tl]);
            __builtin_amdgcn_wave_barrier();
            vec[192 + tl] = 1.f / dmax;
            __builtin_amdgcn_wave_barrier();
#pragma unroll
            for (int r = 0; r < 16; ++r) {
                const int tr_ = (r & 3) + 8 * (r >> 2) + 4 * hi + 32 * tb;
                const float idn = vec[192 + tr_];
                const bf16_t* og = zb + (size_t)(64 * c + tr_) * NZ + ZC_AO + h * 64 + r32;
                const float v0 = H0[r] * idn * sigmoidf_(bf2f(og[0])), v1 = H1[r] * idn * sigmoidf_(bf2f(og[32]));
                float s = v0 + v1;
#pragma unroll
                for (int o = 1; o < 32; o <<= 1) s += __shfl_xor(s, o);
                const float mu = s * (1.f / 64.f), d0 = v0 - mu, d1 = v1 - mu;
                float q2 = d0 * d0 + d1 * d1;
#pragma unroll
                for (int o = 1; o < 32; o <<= 1) q2 += __shfl_xor(q2, o);
                const float rs = rsqrtf(q2 * (1.f / 64.f) + LN_EPS);
                bf16_t* dst = MIX + ((size_t)b * SEQ + 64 * c + tr_) * D + MIX_A + h * 64 + r32;
                dst[0] = f2bf(d0 * rs * norm_g[h * 64 + r32]); dst[32] = f2bf(d1 * rs * norm_g[h * 64 + 32 + r32]);
            }
        }
    }
}

constexpr int CMP_PART = FA_STG;
constexpr int CMP_HID = CMP_PART + 8 * 16384;
constexpr int CMP_HSTR = 528;
__device__ __forceinline__ void nsa_compress_fast(const bf16_t* Z, const float* pos, const bf16_t* W1T, const bf16_t* W2T, bf16_t* KV, unsigned char* lds_gen) {
    LAS3 unsigned char* lds = (LAS3 unsigned char*)lds_gen;
    for (int item = blockIdx.x; item < 2 * 127; item += gridDim.x) {
        int tid = threadIdx.x; asm volatile("" : "+v"(tid));
        const int lane = tid & 63, w = __builtin_amdgcn_readfirstlane(tid >> 6), l15 = lane & 15, quad = lane >> 4;
        const int which = item / 127, g = item % 127;
        const int zc = which == 0 ? ZC_DKC : ZC_DVC;
        const int r = 16 * g + l15, b = r / NCMP, c = r % NCMP;
        const bf16_t* zrow = Z + ((size_t)b * SEQ + 16 * c) * NZ + zc;
        const float* pw = pos + which * 2048;
        const bf16_t* w1 = W1T + (size_t)which * 256 * 2048 + (size_t)l15 * 2048 + 8 * quad;
        f32x4 acc[16];
#pragma unroll
        for (int nb = 0; nb < 16; ++nb) acc[nb] = (f32x4){0.f, 0.f, 0.f, 0.f};
        __syncthreads();
#pragma unroll 2
        for (int kk = 8 * w; kk < 8 * w + 8; ++kk) {
            const int k = 32 * kk + 8 * quad, p = k >> 6, d = k & 63;
            const u32x4v zv = *(const u32x4v*)(zrow + (size_t)p * NZ + d);
            const f32x4 p0 = *(const f32x4*)(pw + k), p1 = *(const f32x4*)(pw + k + 4);
            typedef unsigned u32x4_ __attribute__((ext_vector_type(4)));
            u32x4_ pk;
            pk[0] = cvtpk(__uint_as_float(zv[0] << 16) + p0[0], __uint_as_float(zv[0] & 0xffff0000u) + p0[1]);
            pk[1] = cvtpk(__uint_as_float(zv[1] << 16) + p0[2], __uint_as_float(zv[1] & 0xffff0000u) + p0[3]);
            pk[2] = cvtpk(__uint_as_float(zv[2] << 16) + p1[0], __uint_as_float(zv[2] & 0xffff0000u) + p1[1]);
            pk[3] = cvtpk(__uint_as_float(zv[3] << 16) + p1[2], __uint_as_float(zv[3] & 0xffff0000u) + p1[3]);
            const bf16x8 bfrag = __builtin_bit_cast(bf16x8, pk);
#pragma unroll
            for (int nb = 0; nb < 16; ++nb) {
                const bf16x8 afrag = *(const bf16x8*)(w1 + (size_t)(16 * nb) * 2048 + 32 * kk);
                acc[nb] = __builtin_amdgcn_mfma_f32_16x16x32_bf16(afrag, bfrag, acc[nb], 0, 0, 0);
            }
        }
        {
            LAS3 float* part = (LAS3 float*)(lds + CMP_PART) + w * 4096;
#pragma unroll
            for (int nb = 0; nb < 16; ++nb)
#pragma unroll
                for (int j = 0; j < 4; ++j) part[(nb * 4 + j) * 64 + lane] = acc[nb][j];
        }
        __syncthreads();
        {
            const LAS3 float* part = (const LAS3 float*)(lds + CMP_PART);
#pragma unroll
            for (int q = 0; q < 2; ++q) {
                const int nb = 2 * w + q;
#pragma unroll
                for (int j = 0; j < 4; ++j) {
                    float s = 0.f;
#pragma unroll
                    for (int ww = 0; ww < 8; ++ww) s += part[ww * 4096 + (nb * 4 + j) * 64 + lane];
                    const int n = 16 * nb + 4 * quad + j;
                    *(LAS3 bf16_t*)(lds + CMP_HID + l15 * CMP_HSTR + n * 2) = f2bf(siluf_(s));
                }
            }
        }
        __syncthreads();
        if (w < 4) {
            f32x4 o = (f32x4){0.f, 0.f, 0.f, 0.f};
            const bf16_t* w2 = W2T + (size_t)which * 64 * 256 + (size_t)(16 * w + l15) * 256 + 8 * quad;
#pragma unroll
            for (int s = 0; s < 8; ++s) {
                const bf16x8 a = *(const LAS3 bf16x8*)(lds + CMP_HID + l15 * CMP_HSTR + (32 * s + 8 * quad) * 2);
                const bf16x8 bq = *(const bf16x8*)(w2 + 32 * s);
                o = __builtin_amdgcn_mfma_f32_16x16x32_bf16(a, bq, o, 0, 0, 0);
            }
#pragma unroll
            for (int j = 0; j < 4; ++j) {
                const int rr = 16 * g + 4 * quad + j, bb = rr / NCMP, cc = rr % NCMP;
                KV[(size_t)which * BATCH * 128 * 64 + ((size_t)bb * 128 + cc) * 64 + 16 * w + l15] = f2bf(o[j]);
            }
        }
    }
}

constexpr int LDS_BYTES = 163840;
constexpr int NPH_PRO = 1, NPH_LAYER = 8;
constexpr int NPHASES = NPH_PRO + DEPTH * NPH_LAYER;

__global__ void __launch_bounds__(512, 2) mega(Params p) {
    extern __shared__ __attribute__((aligned(16))) unsigned char lds_raw[];
    float* lds = (float*)lds_raw;
    PG8_LAS unsigned char* glds = (PG8_LAS unsigned char*)lds_raw;
    cg::grid_group grid = cg::this_grid();
    unsigned char* ws = p.ws;
    bf16_t* WIN = (bf16_t*)(ws + WS_WIN); bf16_t* WOUT = (bf16_t*)(ws + WS_WOUT); bf16_t* WFF1 = (bf16_t*)(ws + WS_WFF1); bf16_t* WFF2 = (bf16_t*)(ws + WS_WFF2);
    float* BINP = (float*)(ws + WS_BINP); bf16_t* KV = (bf16_t*)(ws + WS_KCMP); float* MU = (float*)(ws + WS_MU); float* MSM = (float*)(ws + WS_MSM);
    float* ZS = (float*)(ws + WS_ZS); bf16_t* XB = (bf16_t*)(ws + WS_XB); bf16_t* X1 = (bf16_t*)(ws + WS_X1); bf16_t* Z = (bf16_t*)(ws + WS_Z);
    bf16_t* CW1 = (bf16_t*)(ws + WS_CW1); bf16_t* CW2 = (bf16_t*)(ws + WS_CW2);
    float* PBO = (float*)(ws + WS_XB); float* PBL = (float*)(ws + WS_XB + 100 * MiB);
    bf16_t* MIX = (bf16_t*)(ws + WS_MIX); bf16_t* HID = (bf16_t*)(ws + WS_HID); float* Y1 = (float*)(ws + WS_Y1);
    float* bt = lds;
    float* qs_all = lds + 2048;
    float* ps_all = lds + 2048 + 2048;
    float* big = lds + 8192;

#define PH_BEGIN(k) if (p.ph_lo < (k) && (k) < p.ph_hi) grid.sync(); if (p.ph_lo <= (k) && (k) < p.ph_hi)
    PH_BEGIN(0) {
#pragma unroll
        for (int l = 0; l < DEPTH; ++l) {
            int dummy = 0;
            transpose_convert<true>(p.w_in + (size_t)l * D * DIN, D, DIN, WIN + (size_t)l * NZ * D, NZ, big, 0, dummy);
            transpose_convert<false>(p.w_out + (size_t)l * D * D, D, D, WOUT + (size_t)l * D * D, D, big, 0, dummy);
            transpose_convert<false>(p.w_ff1 + (size_t)l * D * DFF, D, DFF, WFF1 + (size_t)l * DFF * D, DFF, big, 0, dummy);
            transpose_convert<false>(p.w_ff2 + (size_t)l * DFF * D, DFF, D, WFF2 + (size_t)l * D * DFF, D, big, 0, dummy);
            for (int wh = 0; wh < 2; ++wh) {
                transpose_convert<false>(p.cmp_w1 + (size_t)(l * 2 + wh) * 2048 * 256, 2048, 256, CW1 + (size_t)(l * 2 + wh) * 256 * 2048, 256, big, 0, dummy);
                transpose_convert<false>(p.cmp_w2 + (size_t)(l * 2 + wh) * 256 * 64, 256, 64, CW2 + (size_t)(l * 2 + wh) * 64 * 256, 64, big, 0, dummy);
            }
        }
        for (int i = blockIdx.x * 512 + threadIdx.x; i < DEPTH * NZ; i += gridDim.x * 512) { const int l = i / NZ, n = i % NZ, o = orig_col(n); BINP[i] = o >= 0 ? p.b_in[l * DIN + o] : 0.f; }
        for (size_t i = (size_t)blockIdx.x * 512 + threadIdx.x; i < (size_t)M * D / 4; i += (size_t)gridDim.x * 512) {
            const f32x4 v = ((const f32x4*)p.x)[i]; uint2 o; o.x = pk2(v[0], v[1]); o.y = pk2(v[2], v[3]); ((uint2*)XB)[i] = o;
        }
    }
#define LAYER_BODY(l) { \
        const int pb = 1 + l * NPH_LAYER; \
        const float* resid = l == 0 ? p.x : p.out; \
        PH_BEGIN(pb + 0) { pg8::Gemm g{XB, WIN + (size_t)l * NZ * D, M, NZ, D}; pg8::StaticOrder S; S.init(M, NZ, (int)gridDim.x, (int)blockIdx.x); pg8::EpiZ e{Z, ZS, BINP + l * NZ}; pg8::gemm_phase<pg8::EpiZ, pg8::StaticOrder, PG8_ALIGN, PG8_SP2>(glds, g, S, e); } \
        PH_BEGIN(pb + 1) { \
            fill_bias_table(bt, p.rel_bias); __syncthreads(); \
            mlstm_local_fast(Z, ZS, p.a_conv + l * 4 * 256, MU, MSM, lds_raw); \
            __syncthreads(); \
            nsa_compress_fast(Z, p.cmp_pos + (size_t)l * 2 * 2048, CW1 + (size_t)l * 2 * 256 * 2048, CW2 + (size_t)l * 2 * 64 * 256, KV, lds_raw); \
            __syncthreads(); \
            __syncthreads(); mixer_b_fast(Z, PBO, PBL, lds_raw); \
            __syncthreads(); mixer_c_fast(Z, ZS, MIX, lds_raw); \
        } \
        PH_BEGIN(pb + 2) { \
            fill_bias_table(bt, p.rel_bias); __syncthreads(); \
            mlstm_out_fast(Z, ZS, p.a_conv + l * 4 * 256, MU, MSM, p.a_norm + l * 256, MIX, lds_raw); \
            __syncthreads(); \
            mixer_d_fast(Z, ZS, KV, MIX, lds_raw); \
            mixer_b_combine(PBO, PBL, MIX); \
        } \
        PH_BEGIN(pb + 3) { pg8::Gemm g{MIX, WOUT + (size_t)l * D * D, M, D, D}; pg8::StaticOrder S; S.init(M, D, (int)gridDim.x, (int)blockIdx.x); pg8::EpiY e{Y1, resid, nullptr, p.b_out + l * D}; pg8::gemm_phase<pg8::EpiY, pg8::StaticOrder, PG8_ALIGN, PG8_SP2>(glds, g, S, e); } \
        PH_BEGIN(pb + 4) { ln_pass(Y1, p.ln1_g + l * D, p.ln1_b + l * D, nullptr, X1); } \
        PH_BEGIN(pb + 5) { pg8::Gemm g{X1, WFF1 + (size_t)l * DFF * D, M, DFF, D}; pg8::StaticOrder S; S.init(M, DFF, (int)gridDim.x, (int)blockIdx.x); pg8::EpiH e{HID, p.b_ff1 + l * DFF}; pg8::gemm_phase<pg8::EpiH, pg8::StaticOrder, PG8_ALIGN, PG8_SP2>(glds, g, S, e); } \
        PH_BEGIN(pb + 6) { pg8::Gemm g{HID, WFF2 + (size_t)l * D * DFF, M, D, DFF}; pg8::StaticOrder S; S.init(M, D, (int)gridDim.x, (int)blockIdx.x); pg8::EpiY e{p.out, nullptr, X1, p.b_ff2 + l * D}; pg8::gemm_phase<pg8::EpiY, pg8::StaticOrder, PG8_ALIGN, PG8_SP2>(glds, g, S, e); } \
        PH_BEGIN(pb + 7) { ln_pass(p.out, p.ln2_g + l * D, p.ln2_b + l * D, p.out, XB); } \
    }
    LAYER_BODY(0)
    LAYER_BODY(1)
}

extern "C" void kernel_launch(void* const* d_in, const int* in_sizes, int n_in, void* d_out, int out_size, void* d_ws, size_t ws_size, hipStream_t stream) {
    static int grid = 0;
    if (grid == 0) {
        if (n_in != 19 || in_sizes[0] != M * D || out_size != M * D || ws_size < WS_END) {
            fprintf(stderr, "kernel_launch: unexpected shapes n_in %d in0 %d out %d ws %zu (need %zu)\n", n_in, n_in > 0 ? in_sizes[0] : -1, out_size, ws_size, (size_t)WS_END);
            grid = -1; return;
        }
        int dev = 0, cus = 0, per_cu = 0;
        hipGetDevice(&dev);
        hipDeviceGetAttribute(&cus, hipDeviceAttributeMultiprocessorCount, dev);
        hipFuncSetAttribute((const void*)mega, hipFuncAttributeMaxDynamicSharedMemorySize, LDS_BYTES);
        hipOccupancyMaxActiveBlocksPerMultiprocessor(&per_cu, (const void*)mega, 512, LDS_BYTES);
        if (per_cu < 1) { fprintf(stderr, "kernel_launch: occupancy query says %d blocks/CU\n", per_cu); per_cu = 1; }
        grid = cus;
        (void)hipGetLastError();
    }
    if (grid < 0) return;
    Params p{};
    const float** pp = (const float**)&p;
    for (int i = 0; i < 19; ++i) pp[i] = (const float*)d_in[i];
    p.out = (float*)d_out; p.ws = (unsigned char*)d_ws;
    p.ph_lo = 0; p.ph_hi = NPHASES;
    void* args[] = {&p};
    hipError_t e = hipLaunchCooperativeKernel((const void*)mega, dim3(grid), dim3(512), args, LDS_BYTES, stream);
    if (e != hipSuccess) fprintf(stderr, "cooperative launch failed: %s (grid %d)\n", hipGetErrorString(e), grid);
}
```
